# Optimizing an MI355X kernel written in HIP

```python
import jax, jax.numpy as jnp
from jax import lax
import numpy as np

D_MODEL = 1024
BATCH = 8
SEQ = 4096
DEPTH = 1
DEC_BATCH = 32
DEC_SEQ = 8
PAST_LEN = 16384
PAGE_SIZE = 128

CONV_CH = D_MODEL
CONV_WIDTH = 31
N_SLOTS = 8
HEAD_DIM = 64
GROUPS = ((128, 1), (512, 4), (2048, 16))
N_GROUPS = len(GROUPS)
ATT_W = N_SLOTS * HEAD_DIM
QKV_W = N_GROUPS * ATT_W
Q_BLK = 128
ALPHA = (2.0 * DEPTH) ** 0.25
BETA = (8.0 * DEPTH) ** -0.25
LN_EPS = 1e-5
SPLITS = (CONV_CH, CONV_CH, CONV_CH, QKV_W, QKV_W, QKV_W, ATT_W, D_MODEL, D_MODEL)
IN_W = sum(SPLITS)

kernel_name = "gated_conformer_dilated_alibi_deepnorm_step"


def layer_norm(x, g, b):
    xf = x.astype(jnp.float32)
    mu = xf.mean(-1, keepdims=True)
    var = jnp.square(xf - mu).mean(-1, keepdims=True)
    y = (xf - mu) * lax.rsqrt(var + LN_EPS) * g.astype(jnp.float32) + b.astype(jnp.float32)
    return y.astype(x.dtype)


def alibi_slopes():
    return 2.0 ** (-8.0 * jnp.arange(1, N_SLOTS + 1, dtype=jnp.float32) / N_SLOTS)


def in_projection(x, w_in, b_in):
    h = jnp.einsum('bsd,de->bse', x, w_in) + b_in
    offs = np.cumsum(SPLITS)[:-1].tolist()
    a_val, a_gate, z_a, q, k, v, z_b, g_a, g_b = jnp.split(h, offs, axis=-1)
    u = a_val * jax.nn.sigmoid(a_gate)
    B, S = x.shape[0], x.shape[1]
    shp = (B, S, N_GROUPS, N_SLOTS, HEAD_DIM)
    q = q.reshape(shp) * (HEAD_DIM ** -0.5)
    return u, z_a, q, k.reshape(shp), v.reshape(shp), z_b, g_a, g_b


def depthwise_valid(u_hist, conv_w):
    return lax.conv_general_dilated(u_hist, conv_w[:, None, :], window_strides=(1,), padding='VALID',
                                    dimension_numbers=('NWC', 'WIO', 'NWC'), feature_group_count=CONV_CH)


def dilated_prompt(q, k, v, window, dil, slopes):
    B, S, H, Dh = q.shape
    steps = window // dil
    span = dil * Q_BLK
    s_pad = -(-S // span) * span
    nb = s_pad // span
    pad = ((0, 0), (0, s_pad - S), (0, 0), (0, 0))
    blk = lambda t: jnp.pad(t, pad).reshape(B, nb, Q_BLK, dil, H, Dh)
    qb, kb, vb = blk(q), blk(k), blk(v)

    def with_prev(t):
        prev = jnp.pad(t[:, :-1], ((0, 0), (1, 0), (0, 0), (0, 0), (0, 0), (0, 0)))
        return jnp.concatenate([prev, t], axis=2)

    kk, vv = with_prev(kb), with_prev(vb)
    s = jnp.einsum('bnirhd,bnjrhd->bnrhij', qb, kk, preferred_element_type=jnp.float32)
    i = jnp.arange(Q_BLK)[:, None]
    j = jnp.arange(2 * Q_BLK)[None, :]
    delta = i + Q_BLK - j
    n = jnp.arange(nb)[:, None, None]
    valid = (delta >= 0) & (delta <= steps) & ((n > 0) | (j >= Q_BLK))
    bias = -slopes[:, None, None] * (delta * dil).astype(jnp.float32)
    s = jnp.where(valid[None, :, None, None], s + bias, -jnp.inf)
    lse = jax.nn.logsumexp(s, axis=-1)
    p = jnp.exp(s - lse[..., None]).astype(v.dtype)
    o = jnp.einsum('bnrhij,bnjrhd->bnirhd', p, vv)
    o = o.reshape(B, s_pad, H, Dh)[:, :S]
    lse = lse.transpose(0, 1, 4, 2, 3).reshape(B, s_pad, H)[:, :S]
    return o, lse


def dilated_sample(q, kv_buf, k, v, window, dil, slopes):
    T = q.shape[1]
    wb = kv_buf.shape[1]
    steps = window // dil
    kcat = jnp.concatenate([kv_buf[:, :, 0], k], axis=1)
    vcat = jnp.concatenate([kv_buf[:, :, 1], v], axis=1)
    jstep = jnp.arange(steps + 1)
    idx = wb + jnp.arange(T)[:, None] - jstep[None, :] * dil
    valid = idx >= 0
    idxc = jnp.maximum(idx, 0)
    kg = kcat[:, idxc]
    vg = vcat[:, idxc]
    s = jnp.einsum('bthd,btkhd->bhtk', q, kg, preferred_element_type=jnp.float32)
    s = s - slopes[:, None, None] * (jstep * dil).astype(jnp.float32)[None, None, :]
    s = jnp.where(valid, s, -jnp.inf)
    lse = jax.nn.logsumexp(s, axis=-1)
    p = jnp.exp(s - lse[..., None]).astype(v.dtype)
    o = jnp.einsum('bhtk,btkhd->bthd', p, vg)
    new_buf = jnp.stack([kcat, vcat], axis=2)[:, -wb:]
    return o, lse.transpose(0, 2, 1), new_buf


def combine_groups(outs, lses):
    o = jnp.stack(outs, axis=2)
    w = jax.nn.softmax(jnp.stack(lses, axis=2), axis=2)
    o = jnp.sum(w[..., None].astype(o.dtype) * o, axis=2)
    return o.reshape(o.shape[0], o.shape[1], ATT_W)


def merge_and_norm(x, conv_raw, attn, z_a, z_b, g_a, g_b, conv_b, conv_ln_g, conv_ln_b,
                   w_a, w_b, w_out, ln_g, ln_b):
    c = jax.nn.silu(layer_norm(conv_raw + conv_b, conv_ln_g, conv_ln_b))
    pa = jnp.einsum('bsc,cd->bsd', c * jax.nn.silu(z_a), w_a)
    pb = jnp.einsum('bsc,cd->bsd', attn * jax.nn.silu(z_b), w_b)
    m = jax.nn.sigmoid(g_a) * pa + jax.nn.sigmoid(g_b) * pb
    o = jnp.einsum('bsd,de->bse', m, w_out)
    return layer_norm(ALPHA * x + o, ln_g, ln_b)


def setup_inputs(seed: int = 0) -> dict:
    key = jax.random.key(seed)
    ks = jax.random.split(key, 20)
    f32 = jnp.float32
    nrm = lambda k, shp: jax.random.normal(k, shp, f32)
    x_prompt = nrm(ks[0], (BATCH, SEQ, D_MODEL))
    x_sample = nrm(ks[1], (DEC_BATCH, DEC_SEQ, D_MODEL))
    caches = []
    for g, (win, dil) in enumerate(GROUPS):
        wb = min(win, PAST_LEN)
        caches.append(nrm(ks[2 + g], (DEC_BATCH, wb, 2, N_SLOTS, HEAD_DIM)))
    state_conv = 0.5 * nrm(ks[5], (DEC_BATCH, CONV_WIDTH - 1, CONV_CH))
    col_scale = np.ones((IN_W,), np.float32)
    v_start = 3 * CONV_CH + 2 * QKV_W
    col_scale[v_start:v_start + QKV_W] = BETA
    w_in = nrm(ks[6], (D_MODEL, IN_W)) * (D_MODEL ** -0.5) * jnp.asarray(col_scale)
    b_in = 0.01 * nrm(ks[7], (IN_W,))
    conv_w = nrm(ks[8], (CONV_WIDTH, CONV_CH)) * (CONV_WIDTH ** -0.5)
    conv_b = 0.01 * nrm(ks[9], (CONV_CH,))
    conv_ln_g = 1.0 + 0.01 * nrm(ks[10], (CONV_CH,))
    conv_ln_b = 0.01 * nrm(ks[11], (CONV_CH,))
    w_a = nrm(ks[12], (CONV_CH, D_MODEL)) * (CONV_CH ** -0.5) * BETA
    w_b = nrm(ks[13], (ATT_W, D_MODEL)) * (ATT_W ** -0.5) * BETA
    w_out = nrm(ks[14], (D_MODEL, D_MODEL)) * (D_MODEL ** -0.5) * BETA
    ln_g = 1.0 + 0.01 * nrm(ks[15], (D_MODEL,))
    ln_b = 0.01 * nrm(ks[16], (D_MODEL,))
    return {'x_prompt': x_prompt, 'x_sample': x_sample,
            'cache_kv_w128': caches[0], 'cache_kv_w512': caches[1], 'cache_kv_w2048': caches[2],
            'state_conv': state_conv,
            'w_in': w_in, 'b_in': b_in, 'conv_w': conv_w, 'conv_b': conv_b,
            'conv_ln_g': conv_ln_g, 'conv_ln_b': conv_ln_b,
            'w_a': w_a, 'w_b': w_b, 'w_out': w_out, 'ln_g': ln_g, 'ln_b': ln_b}


def reference(x_prompt, x_sample, cache_kv_w128, cache_kv_w512, cache_kv_w2048, state_conv,
              w_in, b_in, conv_w, conv_b, conv_ln_g, conv_ln_b, w_a, w_b, w_out, ln_g, ln_b):
    slopes = alibi_slopes()
    assert DEPTH == 1
    y_p, y_s = x_prompt, x_sample
    for _layer in range(DEPTH):
        S = y_p.shape[1]
        u, z_a, q, k, v, z_b, g_a, g_b = in_projection(y_p, w_in, b_in)
        u_hist = jnp.pad(u, ((0, 0), (CONV_WIDTH - 1, 0), (0, 0)))
        conv_raw = depthwise_valid(u_hist, conv_w)
        conv_p = u_hist[:, -(CONV_WIDTH - 1):]
        outs, lses, kv_p = [], [], []
        for g, (win, dil) in enumerate(GROUPS):
            o, l = dilated_prompt(q[:, :, g], k[:, :, g], v[:, :, g], win, dil, slopes)
            outs.append(o)
            lses.append(l)
            keep = min(win, S)
            kv_p.append(jnp.stack([k[:, S - keep:, g], v[:, S - keep:, g]], axis=2))
        attn = combine_groups(outs, lses)
        y_p = merge_and_norm(y_p, conv_raw, attn, z_a, z_b, g_a, g_b, conv_b, conv_ln_g, conv_ln_b,
                             w_a, w_b, w_out, ln_g, ln_b)

        u, z_a, q, k, v, z_b, g_a, g_b = in_projection(y_s, w_in, b_in)
        u_hist = jnp.concatenate([state_conv.astype(u.dtype), u], axis=1)
        conv_raw = depthwise_valid(u_hist, conv_w)
        conv_s = u_hist[:, -(CONV_WIDTH - 1):]
        bufs = (cache_kv_w128, cache_kv_w512, cache_kv_w2048)
        outs, lses, kv_s = [], [], []
        for g, (win, dil) in enumerate(GROUPS):
            o, l, nb_ = dilated_sample(q[:, :, g], bufs[g].astype(k.dtype), k[:, :, g], v[:, :, g], win, dil, slopes)
            outs.append(o)
            lses.append(l)
            kv_s.append(nb_)
        attn = combine_groups(outs, lses)
        y_s = merge_and_norm(y_s, conv_raw, attn, z_a, z_b, g_a, g_b, conv_b, conv_ln_g, conv_ln_b,
                             w_a, w_b, w_out, ln_g, ln_b)
    return (y_p, y_s, kv_p[0], kv_p[1], kv_p[2], conv_p, kv_s[0], kv_s[1], kv_s[2], conv_s)
```

```cpp
#include <hip/hip_runtime.h>
#include <hip/hip_cooperative_groups.h>
#include <cstdio>
#include <cstdint>
#include <cmath>
namespace cg = cooperative_groups;
#define REP_P0 1
#define REP_P1 1
#define REP_ATT 1
#define REP_SATT 1
#define REP_CONV 1
#define REP_COMB 1
#define REP_P3 1
#define REP_P4 1
#define REP_P5 1
#define REP_SYNC 0
namespace pg8 {
#define PG8_LAS __attribute__((address_space(3)))
typedef unsigned short bf16_t;
typedef short bf16x8 __attribute__((ext_vector_type(8)));
typedef float f32x4 __attribute__((ext_vector_type(4)));
typedef unsigned u32x4 __attribute__((ext_vector_type(4)));
constexpr int BM = 256, BK = 64, HALF = 128, HTB = HALF * BK * 2  , STAGE_BYTES = 8 * HTB, NXCD = 8, WGM = 8;

__host__ __device__ __forceinline__ int lds_byte(int r, int c) { const int st = (r >> 4) * 2 + (c >> 5), rr = r & 15, cc = c & 31, ob = rr * 64 + cc * 2; return st * 1024 + (ob ^ (((ob >> 9) & 1) << 5)); }
__host__ __device__ __forceinline__ void stage_rc(int b, int& R, int& C) { const int st = b / 1024, sb = b % 1024, swz = sb ^ (((sb >> 9) & 1) << 5); R = (st >> 1) * 16 + swz / 64; C = (st & 1) * 32 + (swz % 64) / 2; }
__host__ __device__ __forceinline__ int perm32(int rho) { const int n = rho >> 4, i = rho & 15; return 8 * (i >> 2) + 4 * n + (i & 3); }

struct Unit { int pm, pn; };
struct Gemm { const bf16_t* A; const bf16_t* Bt; int M, N, K; };

struct StaticOrder {
    int nM, nN, nwg, G, c;
    __host__ __device__ void init(int M, int N, int G_, int c_) { nM = M / BM; nN = N / BM; nwg = nM * nN; G = G_; c = c_; }
    __host__ __device__ bool next(int i, Unit& u) const {
        const long L = (long)i * G + c; if (L >= nwg) return false;
        int wgid = (int)L; { const int q = nwg / NXCD, r = nwg % NXCD, xcd = wgid % NXCD, off = wgid / NXCD; wgid = (xcd < r ? xcd * (q + 1) : r * (q + 1) + (xcd - r) * q) + off; }
        const int nig = WGM * nN, gid = wgid / nig, fm = gid * WGM, gsz = (nM - fm) < WGM ? (nM - fm) : WGM;
        u.pm = fm + ((wgid % nig) % gsz); u.pn = (wgid % nig) / gsz; return true;
    }
    __device__ __forceinline__ void a_ready(const Unit&) const {}
    __device__ __forceinline__ void done(const Unit&) const {}
};

typedef unsigned u32x4 __attribute__((ext_vector_type(4)));
__device__ __forceinline__ unsigned cvt_pk_bf16(float lo, float hi) { unsigned r; asm volatile("v_cvt_pk_bf16_f32 %0, %1, %2" : "=v"(r) : "v"(lo), "v"(hi)); return r; }
__device__ __forceinline__ float bf_lo(unsigned u) { return __uint_as_float(u << 16); }
__device__ __forceinline__ float bf_hi(unsigned u) { return __uint_as_float(u & 0xffff0000u); }
__device__ __forceinline__ float sigm(float x) { return __builtin_amdgcn_rcpf(1.0f + __builtin_amdgcn_exp2f(-1.4426950408889634f * x)); }
constexpr int HP = 2560;
constexpr int HSP = 4608;

template <int WB> struct KvsCopy {
    static constexpr size_t per = (size_t)(WB - 8) * 256, tot = 32 * per;
    static __device__ __forceinline__ void load(const float* src, size_t base, f32x4 (&v)[9]) {
        const size_t b0 = base / per, w0 = base % per;
#pragma unroll
        for (int k = 0; k < 9; ++k) { size_t b = b0, w = w0 + (size_t)k * 512; if (w >= per) { w -= per; ++b; }
            if (b < 32) v[k] = __builtin_nontemporal_load((const f32x4*)src + b * (size_t)WB * 256 + 8 * 256 + w); }
    }
    static __device__ __forceinline__ void store(float* dst, size_t base, const f32x4 (&v)[9]) {
        const size_t b0 = base / per, w0 = base % per;
#pragma unroll
        for (int k = 0; k < 9; ++k) { size_t b = b0, w = w0 + (size_t)k * 512; if (w >= per) { w -= per; ++b; }
            if (b < 32) __builtin_nontemporal_store(v[k], (f32x4*)dst + b * (size_t)WB * 256 + w); }
    }
};
constexpr int KVS_U2 = 3627, KVS_U1 = 896, KVS_U0 = 214;

struct EpiIn {
    static constexpr bool PERM = true, AFTER_DRAIN = false, HAS_MID = false; static constexpr int MID_T = 0;
    bf16_t* Hb; bf16_t* Hs; bf16_t* U; bf16_t* ZA; bf16_t* QKVh; const float* bias; float qs; const float *c0, *c1, *c2; float *o0, *o1, *o2;
    __device__ __forceinline__ void mid(f32x4 (&acc)[2][2][4][2], const Unit& u, int wr, int wc, int fr, int fq) const {}
    __device__ __forceinline__ void operator()(const f32x4 (&acc)[2][2][4][2], const Unit& u, int wr, int wc, int fr, int fq) const {
        const int flat = u.pm * 40 + u.pn;
        int ct_; asm volatile("v_mov_b32 %0, %1" : "=v"(ct_) : "v"((int)threadIdx.x));
        const size_t ctid = (size_t)(unsigned)ct_;
        f32x4 cv[9];
        if (flat < KVS_U2) KvsCopy<2048>::load(c2, (size_t)flat * 4608 + ctid, cv);
        else if (flat < KVS_U2 + KVS_U1) KvsCopy<512>::load(c1, (size_t)(flat - KVS_U2) * 4608 + ctid, cv);
        else if (flat < KVS_U2 + KVS_U1 + KVS_U0) KvsCopy<128>::load(c0, (size_t)(flat - KVS_U2 - KVS_U1) * 4608 + ctid, cv);
        const int row0 = u.pm * BM + wr * 64 + fr;
        const int bcol0 = u.pn * BM + wc * 32 + 8 * fq;
        f32x4 bv[2][2];
#pragma unroll
        for (int bj = 0; bj < 2; ++bj)
#pragma unroll
            for (int n = 0; n < 2; ++n) bv[bj][n] = *(const f32x4*)(bias + bcol0 + bj * HALF + 4 * n);
        if (u.pn < 8) {
            const int col0 = u.pn * 128 + wc * 32 + 8 * fq;
#pragma unroll
            for (int ai = 0; ai < 2; ++ai)
#pragma unroll
                for (int m = 0; m < 4; ++m) { bf16_t* rowp = U + (size_t)(row0 + ai * HALF + m * 16) * 1024 + col0;
                    f32x4 v0 = acc[ai][0][m][0] + bv[0][0], v1 = acc[ai][0][m][1] + bv[0][1], g0 = acc[ai][1][m][0] + bv[1][0], g1 = acc[ai][1][m][1] + bv[1][1];
#pragma unroll
                    for (int i = 0; i < 4; ++i) { v0[i] *= sigm(g0[i]); v1[i] *= sigm(g1[i]); }
                    u32x4 w; w.x = cvt_pk_bf16(v0[0], v0[1]); w.y = cvt_pk_bf16(v0[2], v0[3]); w.z = cvt_pk_bf16(v1[0], v1[1]); w.w = cvt_pk_bf16(v1[2], v1[3]);
                    *(u32x4*)rowp = w; }
        } else if (u.pn >= 12 && u.pn < 30 && u.pm < 128) {
            const int cidx = u.pn - 12, which = cidx / 6, gi = (cidx % 6) >> 1, h0 = ((cidx % 6) & 1) * 4, lg = 2 * gi;
            const float sc = (which == 0) ? qs : 1.0f;
            const int b = u.pm >> 4;
            const int d0 = (wc & 1) * 32 + 8 * fq;
#pragma unroll
            for (int ai = 0; ai < 2; ++ai)
#pragma unroll
                for (int m = 0; m < 4; ++m) { const int t = (row0 + ai * HALF + m * 16) & 4095; const int ti = ((t & ((1 << lg) - 1)) << (12 - lg)) + (t >> lg);
#pragma unroll
                    for (int bj = 0; bj < 2; ++bj) { const int h = h0 + bj * 2 + (wc >> 1);
                        const f32x4 v0 = (acc[ai][bj][m][0] + bv[bj][0]) * sc, v1 = (acc[ai][bj][m][1] + bv[bj][1]) * sc;
                        u32x4 w; w.x = cvt_pk_bf16(v0[0], v0[1]); w.y = cvt_pk_bf16(v0[2], v0[3]); w.z = cvt_pk_bf16(v1[0], v1[1]); w.w = cvt_pk_bf16(v1[2], v1[3]);
                        *(u32x4*)(QKVh + ((size_t)((((which * 8 + b) * 3 + gi) * 8 + h) * 4096 + ti)) * 64 + d0) = w; } }
        } else {
            const int pn = u.pn; const int mode = (pn < 32) ? 0 : 2;   const float sc = (pn >= 12 && pn < 18) ? qs : 1.0f;
            bf16_t* base = (pn < 12) ? ZA + (pn * BM - 2048) : (pn < 30) ? Hs + (pn - 12) * BM - (size_t)32768 * HSP : Hb + (pn - 30) * BM; const int pitch = (pn < 12) ? 1024 : (pn < 30) ? HSP : HP;
            const int col0 = wc * 32 + 8 * fq;
#pragma unroll
            for (int ai = 0; ai < 2; ++ai)
#pragma unroll
                for (int m = 0; m < 4; ++m) { bf16_t* rowp = base + (size_t)(row0 + ai * HALF + m * 16) * pitch + col0;
#pragma unroll
                    for (int bj = 0; bj < 2; ++bj) { f32x4 v0 = acc[ai][bj][m][0] + bv[bj][0], v1 = acc[ai][bj][m][1] + bv[bj][1];
                        if (mode == 0) { v0 = v0 * sc; v1 = v1 * sc; }
                        else {
#pragma unroll
                            for (int i = 0; i < 4; ++i) { const float s0 = sigm(v0[i]), s1 = sigm(v1[i]); v0[i] = (mode == 1) ? v0[i] * s0 : s0; v1[i] = (mode == 1) ? v1[i] * s1 : s1; } }
                        u32x4 w; w.x = cvt_pk_bf16(v0[0], v0[1]); w.y = cvt_pk_bf16(v0[2], v0[3]); w.z = cvt_pk_bf16(v1[0], v1[1]); w.w = cvt_pk_bf16(v1[2], v1[3]);
                        *(u32x4*)(rowp + bj * HALF) = w; } }
        }
        if (flat < KVS_U2) KvsCopy<2048>::store(o2, (size_t)flat * 4608 + ctid, cv);
        else if (flat < KVS_U2 + KVS_U1) KvsCopy<512>::store(o1, (size_t)(flat - KVS_U2) * 4608 + ctid, cv);
        else if (flat < KVS_U2 + KVS_U1 + KVS_U0) KvsCopy<128>::store(o0, (size_t)(flat - KVS_U2 - KVS_U1) * 4608 + ctid, cv);
    }
};

template <bool ADD> struct EpiGate {
    static constexpr bool PERM = true, AFTER_DRAIN = false, HAS_MID = false; static constexpr int MID_T = 0;
    const bf16_t* Hb; bf16_t* Mb; int gcol;
    __device__ __forceinline__ void mid(f32x4 (&acc)[2][2][4][2], const Unit& u, int wr, int wc, int fr, int fq) const {}
    __device__ __forceinline__ void operator()(const f32x4 (&acc)[2][2][4][2], const Unit& u, int wr, int wc, int fr, int fq) const {
        const int row0 = u.pm * BM + wr * 64 + fr, col0 = u.pn * BM + wc * 32 + 8 * fq;
#pragma unroll
        for (int ai = 0; ai < 2; ++ai)
#pragma unroll
            for (int m = 0; m < 4; ++m) { const size_t row = (size_t)(row0 + ai * HALF + m * 16); if (m == 0) asm volatile("" ::: "memory");
#pragma unroll
                for (int bj = 0; bj < 2; ++bj) { const u32x4 a = *(const u32x4*)(Hb + row * HP + gcol + col0 + bj * HALF);
                    u32x4 t = (u32x4){0u, 0u, 0u, 0u}; if (ADD) t = *(const u32x4*)(Mb + row * 1024 + col0 + bj * HALF);
                    const f32x4 v0 = acc[ai][bj][m][0], v1 = acc[ai][bj][m][1];
                    u32x4 w; w.x = cvt_pk_bf16(v0[0] * bf_lo(a.x) + bf_lo(t.x), v0[1] * bf_hi(a.x) + bf_hi(t.x)); w.y = cvt_pk_bf16(v0[2] * bf_lo(a.y) + bf_lo(t.y), v0[3] * bf_hi(a.y) + bf_hi(t.y));
                    w.z = cvt_pk_bf16(v1[0] * bf_lo(a.z) + bf_lo(t.z), v1[1] * bf_hi(a.z) + bf_hi(t.z)); w.w = cvt_pk_bf16(v1[2] * bf_lo(a.w) + bf_lo(t.w), v1[3] * bf_hi(a.w) + bf_hi(t.w));
                    *(u32x4*)(Mb + row * 1024 + col0 + bj * HALF) = w; } }
    }
};

struct EpiOut {
    static constexpr bool PERM = true, AFTER_DRAIN = false, HAS_MID = false; static constexpr int MID_T = 0;
    const float* xp; const float* xs; bf16_t* y; float alpha; int rp;
    __device__ __forceinline__ void mid(f32x4 (&acc)[2][2][4][2], const Unit& u, int wr, int wc, int fr, int fq) const {}
    __device__ __forceinline__ void operator()(const f32x4 (&acc)[2][2][4][2], const Unit& u, int wr, int wc, int fr, int fq) const {
        const int row0 = u.pm * BM + wr * 64 + fr, col0 = u.pn * BM + wc * 32 + 8 * fq;
#pragma unroll
        for (int ai = 0; ai < 2; ++ai)
#pragma unroll
            for (int m = 0; m < 4; ++m) { const int row = row0 + ai * HALF + m * 16; if (m == 0) asm volatile("" ::: "memory");
                const float* xr = (row < rp) ? xp + (size_t)row * 1024 : xs + (size_t)(row - rp) * 1024; bf16_t* yr = y + (size_t)row * 1024;
#pragma unroll
                for (int bj = 0; bj < 2; ++bj) { const f32x4 x0 = *(const f32x4*)(xr + col0 + bj * HALF), x1 = *(const f32x4*)(xr + col0 + bj * HALF + 4);
                    const f32x4 v0 = x0 * alpha + acc[ai][bj][m][0], v1 = x1 * alpha + acc[ai][bj][m][1];
                    u32x4 w; w.x = cvt_pk_bf16(v0[0], v0[1]); w.y = cvt_pk_bf16(v0[2], v0[3]); w.z = cvt_pk_bf16(v1[0], v1[1]); w.w = cvt_pk_bf16(v1[2], v1[3]);
                    *(u32x4*)(yr + col0 + bj * HALF) = w; } }
    }
};

template <class Epi, class Sched, bool ALIGN_EPI = false, bool SP2 = false>
__device__ __forceinline__ void gemm_phase(PG8_LAS unsigned char* lds, const Gemm g, const Sched& S, const Epi& E) {
    int tid_opaque; asm volatile("v_mov_b32 %0, %1" : "=v"(tid_opaque) : "v"((int)threadIdx.x));
    const int tid = tid_opaque, wid = __builtin_amdgcn_readfirstlane(tid >> 6), lane = tid & 63, wr = wid >> 2, wc = wid & 3, fr = lane & 15, fq = lane >> 4;
    const int K = g.K, nt = K / BK;
    unsigned voffA[2], voffB[2];
#pragma unroll
    for (int i = 0; i < 2; ++i) { int R, C; stage_rc(tid * 16 + i * 8192, R, C); const int Rb = Epi::PERM ? ((R & ~31) + perm32(R & 31)) : R;
        voffA[i] = (unsigned)(R * K + C) * 2u; voffB[i] = (unsigned)(Rb * K + C) * 2u; }
    const size_t kstep = (size_t)(BK * 2);
    const size_t hstep = (size_t)HALF * K * 2;
    const size_t tstep = 2 * hstep;
    const unsigned ldsw = (unsigned)wid * 1024u;
    const int aoff = lds_byte(wr * 64 + fr, fq * 8), boff = lds_byte(wc * 32 + fr, fq * 8);
#define PG8_SA(b, h) (((b) * 2 + (h)) * HTB)
#define PG8_SB(b, h) ((4 + (b) * 2 + (h)) * HTB)
#define PG8_STAGE(bufoff, gbase, voff) do { _Pragma("unroll") for (int _i = 0; _i < 2; ++_i) \
        __builtin_amdgcn_global_load_lds((const unsigned*)((const char*)(gbase) + (voff)[_i]), (PG8_LAS unsigned*)(lds + (bufoff) + ldsw + _i * 8192), 16, 0, 0); } while (0)
#define PG8_LDA(dst, b, h) do { _Pragma("unroll") for (int m = 0; m < 4; ++m) _Pragma("unroll") for (int k = 0; k < 2; ++k) dst[m][k] = *(const PG8_LAS bf16x8*)(lds + PG8_SA(b, h) + aoff + m * 2048 + k * 1024); } while (0)
#define PG8_LDB(dst, b, h) do { _Pragma("unroll") for (int n = 0; n < 2; ++n) _Pragma("unroll") for (int k = 0; k < 2; ++k) dst[n][k] = *(const PG8_LAS bf16x8*)(lds + PG8_SB(b, h) + boff + n * 2048 + k * 1024); } while (0)
#define PG8_MMA(ai, bj, At, Bt) do { __builtin_amdgcn_s_setprio(1); _Pragma("unroll") for (int m = 0; m < 4; ++m) _Pragma("unroll") for (int n = 0; n < 2; ++n) _Pragma("unroll") for (int k = 0; k < 2; ++k) \
        acc[ai][bj][m][n] = __builtin_amdgcn_mfma_f32_16x16x32_bf16(Bt[n][k], At[m][k], acc[ai][bj][m][n], 0, 0, 0); __builtin_amdgcn_s_setprio(0); } while (0)
#define PG8_WAIT_V(n) asm volatile("s_waitcnt vmcnt(" #n ")" ::: "memory")
#define PG8_WAIT_L(n) asm volatile("s_waitcnt lgkmcnt(" #n ")" ::: "memory")
#define PG8_BAR __builtin_amdgcn_s_barrier()
#define PG8_SCHED __builtin_amdgcn_sched_barrier(0)
    Unit cur, nxt; int ui = 0;
    if (!S.next(0, cur)) return;
    f32x4 acc[2][2][4][2];
#pragma unroll
    for (int a = 0; a < 2; ++a)
#pragma unroll
        for (int b = 0; b < 2; ++b)
#pragma unroll
            for (int m = 0; m < 4; ++m)
#pragma unroll
                for (int n = 0; n < 2; ++n) acc[a][b][m][n] = (f32x4){0.f, 0.f, 0.f, 0.f};
    bf16x8 At[4][2], B0[2][2], B1[2][2];
    const char* cA = (const char*)g.A + (size_t)cur.pm * tstep; const char* cB = (const char*)g.Bt + (size_t)cur.pn * tstep;
    S.a_ready(cur);
    if constexpr (SP2) {
        PG8_STAGE(PG8_SB(0, 0), cB, voffB); PG8_STAGE(PG8_SB(0, 1), cB + hstep, voffB); PG8_STAGE(PG8_SA(0, 0), cA, voffA); PG8_STAGE(PG8_SA(0, 1), cA + hstep, voffA);
        if (wr == 1) PG8_BAR;
        PG8_WAIT_V(2); PG8_BAR;
        PG8_STAGE(PG8_SB(1, 0), cB + kstep, voffB); PG8_STAGE(PG8_SA(1, 0), cA + kstep, voffA); PG8_STAGE(PG8_SB(1, 1), cB + hstep + kstep, voffB);
        PG8_WAIT_V(6); PG8_BAR;
    } else {
        PG8_STAGE(PG8_SB(0, 0), cB, voffB); PG8_STAGE(PG8_SA(0, 0), cA, voffA); PG8_STAGE(PG8_SB(0, 1), cB + hstep, voffB); PG8_STAGE(PG8_SA(0, 1), cA + hstep, voffA);
        if (wr == 1) PG8_BAR;
        PG8_WAIT_V(4); PG8_BAR;
        PG8_STAGE(PG8_SB(1, 0), cB + kstep, voffB); PG8_STAGE(PG8_SA(1, 0), cA + kstep, voffA); PG8_STAGE(PG8_SB(1, 1), cB + hstep + kstep, voffB);
        PG8_WAIT_V(6); PG8_BAR;
    }
    for (;;) {
        const bool has_next = S.next(ui + 1, nxt);
        const char* nA = has_next ? (const char*)g.A + (size_t)nxt.pm * tstep : cA; const char* nB = has_next ? (const char*)g.Bt + (size_t)nxt.pn * tstep : cB;
        for (int t = 0; t < nt; t += 2) {
            if constexpr (Epi::HAS_MID) { if (t == Epi::MID_T) E.mid(acc, cur, wr, wc, fr, fq); }
            const bool last = (t == nt - 2);
            const char* a1 = cA + (size_t)(t + 1) * kstep;
            const char* a2 = last ? nA : cA + (size_t)(t + 2) * kstep; const char* b2 = last ? nB : cB + (size_t)(t + 2) * kstep;
            const char* a3 = a2 + kstep; const char* b3 = b2 + kstep;
            if (last && has_next) S.a_ready(nxt);
            if constexpr (SP2) {
            PG8_LDB(B0, 0, 0); PG8_LDB(B1, 0, 1); PG8_SCHED; PG8_LDA(At, 0, 0); PG8_STAGE(PG8_SA(1, 1), a1 + hstep, voffA);
            PG8_WAIT_V(8); PG8_WAIT_L(0); PG8_BAR; PG8_MMA(0, 0, At, B0); PG8_MMA(0, 1, At, B1); PG8_BAR; PG8_SCHED;
            PG8_LDA(At, 0, 1); PG8_STAGE(PG8_SB(0, 0), b2, voffB); PG8_STAGE(PG8_SB(0, 1), b2 + hstep, voffB); PG8_STAGE(PG8_SA(0, 0), a2, voffA);
            PG8_WAIT_V(8); PG8_WAIT_L(0); PG8_BAR; PG8_MMA(1, 0, At, B0); PG8_MMA(1, 1, At, B1); PG8_BAR; PG8_SCHED;
            PG8_LDB(B0, 1, 0); PG8_LDB(B1, 1, 1); PG8_SCHED; PG8_LDA(At, 1, 0); PG8_STAGE(PG8_SA(0, 1), a2 + hstep, voffA);
            PG8_WAIT_V(8); PG8_WAIT_L(0); PG8_BAR; PG8_MMA(0, 0, At, B0); PG8_MMA(0, 1, At, B1); PG8_BAR; PG8_SCHED;
            PG8_LDA(At, 1, 1); PG8_STAGE(PG8_SB(1, 0), b3, voffB); PG8_STAGE(PG8_SB(1, 1), b3 + hstep, voffB); PG8_STAGE(PG8_SA(1, 0), a3, voffA);
            PG8_WAIT_V(8); PG8_WAIT_L(0); PG8_BAR; PG8_MMA(1, 0, At, B0); PG8_MMA(1, 1, At, B1); PG8_BAR; PG8_SCHED;
            } else {
            PG8_LDB(B0, 0, 0); PG8_SCHED; PG8_LDA(At, 0, 0); PG8_STAGE(PG8_SA(1, 1), a1 + hstep, voffA);
            PG8_WAIT_L(8); PG8_BAR; PG8_WAIT_L(0); PG8_MMA(0, 0, At, B0); PG8_BAR; PG8_SCHED;
            PG8_LDB(B1, 0, 1); PG8_STAGE(PG8_SB(0, 0), b2, voffB);
            PG8_BAR; PG8_WAIT_L(0); PG8_MMA(0, 1, At, B1); PG8_BAR;
            PG8_LDA(At, 0, 1); PG8_STAGE(PG8_SA(0, 0), a2, voffA);
            PG8_BAR; PG8_WAIT_L(0); PG8_MMA(1, 0, At, B0); PG8_BAR; PG8_SCHED;
            PG8_STAGE(PG8_SB(0, 1), b2 + hstep, voffB);
            PG8_WAIT_V(6); PG8_BAR; PG8_MMA(1, 1, At, B1); PG8_BAR;
            PG8_LDB(B0, 1, 0); PG8_SCHED; PG8_LDA(At, 1, 0); PG8_STAGE(PG8_SA(0, 1), a2 + hstep, voffA);
            PG8_WAIT_L(8); PG8_BAR; PG8_WAIT_L(0); PG8_MMA(0, 0, At, B0); PG8_BAR; PG8_SCHED;
            PG8_LDB(B1, 1, 1); PG8_STAGE(PG8_SB(1, 0), b3, voffB);
            PG8_BAR; PG8_WAIT_L(0); PG8_MMA(0, 1, At, B1); PG8_BAR;
            PG8_LDA(At, 1, 1); PG8_STAGE(PG8_SA(1, 0), a3, voffA);
            PG8_BAR; PG8_WAIT_L(0); PG8_MMA(1, 0, At, B0); PG8_BAR; PG8_SCHED;
            PG8_STAGE(PG8_SB(1, 1), b3 + hstep, voffB);
            PG8_WAIT_V(6); PG8_BAR; PG8_MMA(1, 1, At, B1); PG8_BAR;
            }
        }
        if constexpr (ALIGN_EPI) { if (wr == 0) PG8_BAR; }
        if constexpr (!Epi::AFTER_DRAIN) { E(acc, cur, wr, wc, fr, fq); S.done(cur); }
        if (!has_next) break;
#pragma unroll
        for (int a = 0; a < 2; ++a)
#pragma unroll
            for (int b = 0; b < 2; ++b)
#pragma unroll
                for (int m = 0; m < 4; ++m)
#pragma unroll
                    for (int n = 0; n < 2; ++n) acc[a][b][m][n] = (f32x4){0.f, 0.f, 0.f, 0.f};
        cur = nxt; cA = nA; cB = nB; ++ui;
        if constexpr (ALIGN_EPI) { if (wr == 1) PG8_BAR; }
    }
    PG8_WAIT_V(0);
    if constexpr (!ALIGN_EPI) { if (wr == 0) PG8_BAR; }
    PG8_BAR;
    if constexpr (Epi::AFTER_DRAIN) { E.fused(acc, cur, wr, wc, fr, fq, lds, wid, lane); S.done(cur); }
#undef PG8_SA
#undef PG8_SB
#undef PG8_STAGE
#undef PG8_LDA
#undef PG8_LDB
#undef PG8_MMA
#undef PG8_WAIT_V
#undef PG8_WAIT_L
#undef PG8_BAR
#undef PG8_SCHED
}
}
#define LAS __attribute__((address_space(3)))
typedef unsigned short bf16;
typedef unsigned u32x4 __attribute__((ext_vector_type(4)));
typedef unsigned u32x2 __attribute__((ext_vector_type(2)));
typedef float f32x4 __attribute__((ext_vector_type(4)));
typedef float f32x2 __attribute__((ext_vector_type(2)));
typedef float f32x16 __attribute__((ext_vector_type(16)));
typedef short bf16x8 __attribute__((ext_vector_type(8)));
using pg8::cvt_pk_bf16; using pg8::bf_lo; using pg8::bf_hi; using pg8::sigm; using pg8::HP; using pg8::HSP;

constexpr int NWAVES = 8, NT = 512;
constexpr int D = 1024, SEQ = 4096, NB = 8, RP = NB * SEQ, RS = 256, R = RP + RS, INW = 10240;
constexpr int HC_ZB = 0, HC_GA = 512, HC_GB = 1536;
constexpr int HS_Q = 0, HS_K = 1536, HS_V = 3072;
constexpr float LOG2E = 1.4426950408889634f, LN2 = 0.6931471805599453f;
constexpr float QS = 0.125f * LOG2E;
constexpr float ALPHA = 1.189207115002721f;
constexpr float LN_EPS = 1e-5f;
constexpr size_t MiB = 1u << 20;
constexpr size_t WS_WIN = 0 * MiB, WS_WA = 21 * MiB, WS_WB = 24 * MiB, WS_WO = 26 * MiB, WS_BP = 29 * MiB, WS_XB = 31 * MiB, WS_CA = 97 * MiB, WS_AB = 163 * MiB, WS_MB = 197 * MiB, WS_OG = 263 * MiB, WS_LSE = 361 * MiB, WS_SP = 366 * MiB, WS_HB = 382 * MiB, WS_HS = 545 * MiB, WS_U = 549 * MiB, WS_ZA = 615 * MiB, WS_QKV = 681 * MiB, WS_Y = 970 * MiB, WS_BAR = 1036 * MiB, WS_END = 1038 * MiB;
constexpr size_t O_YP = 0, O_YS = 33554432, O_KVP0 = 33816576, O_KVP1 = 34865152, O_KVP2 = 39059456, O_CONVP = 55836672, O_KVS0 = 56082432, O_KVS1 = 60276736, O_KVS2 = 77053952, O_CONVS = 144162816;
constexpr int RING_BYTES = 131072, LDS_BYTES = 147456, LDS_MISC = LDS_BYTES - 64;

struct Args {
    const float *xp, *xs, *c0, *c1, *c2, *sconv, *w_in, *b_in, *conv_w, *conv_b, *cln_g, *cln_b, *w_a, *w_b, *w_out, *ln_g, *ln_b;
    float* out; unsigned char* ws;
};

#define LDS_WAIT() asm volatile("s_waitcnt lgkmcnt(0)" ::: "memory")

__device__ __forceinline__ void tr_item(const float* W, int ldw, int k0, int n0, bf16* dst, int ldT, LAS float* scr, int lane) {
#pragma unroll 8
    for (int i = 0; i < 32; ++i) { const int kk = 2 * i + (lane >> 5); scr[kk * 33 + (lane & 31)] = W[(size_t)(k0 + kk) * ldw + n0 + (lane & 31)]; }
    LDS_WAIT();
    const int c = lane & 7;
#pragma unroll
    for (int j = 0; j < 4; ++j) { const int n = (lane >> 3) + 8 * j; const LAS float* s = scr + (8 * c) * 33 + n;
        u32x4 o; o.x = cvt_pk_bf16(s[0 * 33], s[1 * 33]); o.y = cvt_pk_bf16(s[2 * 33], s[3 * 33]); o.z = cvt_pk_bf16(s[4 * 33], s[5 * 33]); o.w = cvt_pk_bf16(s[6 * 33], s[7 * 33]);
        *(u32x4*)(dst + (size_t)n * ldT + 8 * c) = o; }
    LDS_WAIT();
}
__device__ __forceinline__ int perm_in(int n) { if (n >= 2048) return n; const int half = n >> 10, c = n & 1023; return (c >> 7) * 256 + half * 128 + (c & 127); }

template <int WB> __device__ __forceinline__ void kvs_copy(const float* src, float* dst, int tid, int G) {
    constexpr size_t per = (size_t)(WB - 8) * 256, tot = 32 * per;
    for (size_t i0 = (size_t)blockIdx.x * NT * 8 + tid; i0 < tot; i0 += (size_t)G * NT * 8) {
        f32x4 v[8];
#pragma unroll
        for (int k = 0; k < 8; ++k) { const size_t i = i0 + (size_t)k * NT; if (i < tot) { const size_t b = i / per, w = i % per; v[k] = __builtin_nontemporal_load((const f32x4*)src + b * (size_t)WB * 256 + 8 * 256 + w); } }
#pragma unroll
        for (int k = 0; k < 8; ++k) { const size_t i = i0 + (size_t)k * NT; if (i < tot) { const size_t b = i / per, w = i % per; __builtin_nontemporal_store(v[k], (f32x4*)dst + b * (size_t)WB * 256 + w); } }
    }
}
__device__ __forceinline__ void phase0(const Args& a, LAS unsigned char* lds, int tid, int lane, int wave, int G) {
    unsigned char* ws = a.ws;
    bf16* WinT = (bf16*)(ws + WS_WIN); bf16* WaT = (bf16*)(ws + WS_WA); bf16* WbT = (bf16*)(ws + WS_WB); bf16* WoT = (bf16*)(ws + WS_WO); float* bp = (float*)(ws + WS_BP); bf16* Xb = (bf16*)(ws + WS_XB);
    LAS float* scr = (LAS float*)(lds + wave * 16384);
    const int gw = blockIdx.x * NWAVES + wave, NGW = G * NWAVES;
    constexpr int I_IN = 16 * 320, I_B = 8 * 32, I_A = 16 * 32, I_O = 16 * 32, NITEMS = I_IN + I_B + I_A + I_O;
    for (int it = gw; it < NITEMS; it += NGW) {
        int r = it;
        if (r < I_IN) { const int kb = r / 320, nb = r % 320; tr_item(a.w_in, INW, 64 * kb, 32 * nb, WinT + (size_t)perm_in(32 * nb) * 1024 + 64 * kb, 1024, scr, lane); continue; } r -= I_IN;
        if (r < I_B) { const int kb = r / 32, nb = r % 32; tr_item(a.w_b, 1024, 64 * kb, 32 * nb, WbT + (size_t)(32 * nb) * 512 + 64 * kb, 512, scr, lane); continue; } r -= I_B;
        if (r < I_A) { const int kb = r / 32, nb = r % 32; tr_item(a.w_a, 1024, 64 * kb, 32 * nb, WaT + (size_t)(32 * nb) * 1024 + 64 * kb, 1024, scr, lane); continue; } r -= I_A;
        { const int kb = r / 32, nb = r % 32; tr_item(a.w_out, 1024, 64 * kb, 32 * nb, WoT + (size_t)(32 * nb) * 1024 + 64 * kb, 1024, scr, lane); }
    }
    for (int n = blockIdx.x * NT + tid; n < INW; n += G * NT) bp[perm_in(n)] = a.b_in[n];
    for (int q = gw; q < R / 4; q += NGW) {
        f32x4 v[4][4];
#pragma unroll
        for (int k = 0; k < 4; ++k) { const int m = 4 * q + k; const f32x4* xr = (const f32x4*)((m < RP) ? a.xp + (size_t)m * D : a.xs + (size_t)(m - RP) * D) + lane;
#pragma unroll
            for (int j = 0; j < 4; ++j) v[k][j] = __builtin_nontemporal_load(xr + 64 * j); }
#pragma unroll
        for (int k = 0; k < 4; ++k) { u32x2* o8 = (u32x2*)(Xb + (size_t)(4 * q + k) * D) + lane;
#pragma unroll
            for (int j = 0; j < 4; ++j) { u32x2 o; o.x = cvt_pk_bf16(v[k][j].x, v[k][j].y); o.y = cvt_pk_bf16(v[k][j].z, v[k][j].w); o8[64 * j] = o; } }
    }
}

constexpr int KS_PITCH = 144, VT_PITCH = 776, LDS_KS = 0, LDS_VT = 384 * KS_PITCH  , LDS_WSF = LDS_VT + 64 * VT_PITCH  ;
struct AttnPre { u32x4 k[6]; u32x4 v0[3]; u32x4 v1[3]; bf16x8 q[4]; };
__device__ __forceinline__ void attn_decode(int uidx, int& b, int& h, int& g, int& d, int& res, int& blk) {
    const int bh = uidx / 48, s = uidx % 48; b = bh >> 3; h = bh & 7;
    if (s < 16) { g = 0; d = 1; res = 0; blk = s; } else if (s < 32) { g = 1; d = 4; res = (s - 16) >> 2; blk = (s - 16) & 3; } else { g = 2; d = 16; res = s - 32; blk = 0; }
}
__device__ __forceinline__ void attn_load(const bf16* QKVh, int uidx, int tid, int lane, int wave, AttnPre& p) {
    int b, h, g, d, res, blk; attn_decode(uidx, b, h, g, d, res, blk);
    const int L = SEQ / d;
    const bf16* Qr = QKVh + ((size_t)((((0 * 8 + b) * 3 + g) * 8 + h) * 4096 + res * L)) * 64;
    const bf16* Kr = QKVh + ((size_t)((((1 * 8 + b) * 3 + g) * 8 + h) * 4096 + res * L)) * 64;
    const bf16* Vr = QKVh + ((size_t)((((2 * 8 + b) * 3 + g) * 8 + h) * 4096 + res * L)) * 64;
    const int i0 = 256 * blk - 128;
#pragma unroll
    for (int i = 0; i < 6; ++i) { const int c = tid + NT * i, kk = c >> 3, ch = c & 7, ik = i0 + kk;
        p.k[i] = (u32x4){0u, 0u, 0u, 0u};
        if (ik >= 0) p.k[i] = *(const u32x4*)(Kr + (size_t)ik * 64 + ch * 8); }
#pragma unroll
    for (int i = 0; i < 3; ++i) { const int c = tid + NT * i, kp = c % 192, ch = c / 192, ik = i0 + 2 * kp;
        p.v0[i] = (u32x4){0u, 0u, 0u, 0u}; p.v1[i] = p.v0[i];
        if (ik >= 0) { p.v0[i] = *(const u32x4*)(Vr + (size_t)ik * 64 + ch * 8); p.v1[i] = *(const u32x4*)(Vr + (size_t)(ik + 1) * 64 + ch * 8); } }
    const int qp = lane & 31, hi = lane >> 5, iq = 256 * blk + 32 * wave + qp;
    const bf16* qr = Qr + (size_t)iq * 64 + 8 * hi;
#pragma unroll
    for (int kd = 0; kd < 4; ++kd) p.q[kd] = *(const bf16x8*)(qr + 16 * kd);
}
__device__ __forceinline__ void attn_stage(LAS unsigned char* lds, const AttnPre& p, int tid) {
#pragma unroll
    for (int i = 0; i < 6; ++i) { const int c = tid + NT * i, kk = c >> 3, ch = c & 7; *(LAS u32x4*)(lds + LDS_KS + kk * KS_PITCH + ch * 16) = p.k[i]; }
#pragma unroll
    for (int i = 0; i < 3; ++i) { const int c = tid + NT * i, kp = c % 192, ch = c / 192; const u32x4 v0 = p.v0[i], v1 = p.v1[i];
        LAS unsigned char* vp = lds + LDS_VT + (8 * ch) * VT_PITCH + 4 * kp;
        *(LAS unsigned*)(vp + 0 * VT_PITCH) = (v0.x & 0xffffu) | (v1.x << 16);  *(LAS unsigned*)(vp + 1 * VT_PITCH) = (v0.x >> 16) | (v1.x & 0xffff0000u);
        *(LAS unsigned*)(vp + 2 * VT_PITCH) = (v0.y & 0xffffu) | (v1.y << 16);  *(LAS unsigned*)(vp + 3 * VT_PITCH) = (v0.y >> 16) | (v1.y & 0xffff0000u);
        *(LAS unsigned*)(vp + 4 * VT_PITCH) = (v0.z & 0xffffu) | (v1.z << 16);  *(LAS unsigned*)(vp + 5 * VT_PITCH) = (v0.z >> 16) | (v1.z & 0xffff0000u);
        *(LAS unsigned*)(vp + 6 * VT_PITCH) = (v0.w & 0xffffu) | (v1.w << 16);  *(LAS unsigned*)(vp + 7 * VT_PITCH) = (v0.w >> 16) | (v1.w & 0xffff0000u); }
}
__device__ __forceinline__ void attn_compute(LAS unsigned char* lds, const bf16x8 (&qf)[4], bf16* Og, float* Lse, int uidx, int tid, int lane, int wave) {
    int b, h, g, d, res, blk; attn_decode(uidx, b, h, g, d, res, blk);
    const int qp = lane & 31, hi = lane >> 5;
    const int iq = 256 * blk + 32 * wave + qp;
    const float cb = -__builtin_amdgcn_exp2f(-(float)(h + 1)) * (float)d * LOG2E;
    const float lb = cb * (float)(qp - 4 * hi);
    f32x16 S[5];
#pragma unroll
    for (int kt = 0; kt < 5; ++kt) {
        const bool tv = !(blk == 0 && wave + kt < 4);
#pragma unroll
        for (int r = 0; r < 16; ++r) S[kt][r] = lb;
        if (tv) {
            const LAS unsigned char* kb = lds + LDS_KS + (32 * wave + 32 * kt + qp) * KS_PITCH + 16 * hi;
#pragma unroll
            for (int kd = 0; kd < 4; ++kd) { const bf16x8 af = *(const LAS bf16x8*)(kb + 32 * kd); S[kt] = __builtin_amdgcn_mfma_f32_32x32x16_bf16(af, qf[kd], S[kt], 0, 0, 0); }
        }
#pragma unroll
        for (int r = 0; r < 16; ++r) { const int kl0 = (r & 3) + 8 * (r >> 2); float v = S[kt][r] + cb * (float)(128 - 32 * kt - kl0);
            const int kl = kl0 + 4 * hi;
            if (kt == 0) { if (kl < qp) v = -INFINITY; }
            if (kt == 4) { if (kl > qp) v = -INFINITY; }
            if (!tv) v = -INFINITY;
            S[kt][r] = v; }
    }
    float mx = -INFINITY;
#pragma unroll
    for (int kt = 0; kt < 5; ++kt)
#pragma unroll
        for (int r = 0; r < 16; ++r) mx = fmaxf(mx, S[kt][r]);
    mx = fmaxf(mx, __shfl_xor(mx, 32));
    float l = 0.f;
#pragma unroll
    for (int kt = 0; kt < 5; ++kt)
#pragma unroll
        for (int r = 0; r < 16; ++r) { const float p = __builtin_amdgcn_exp2f(S[kt][r] - mx); S[kt][r] = p; l += p; }
    l += __shfl_xor(l, 32);
    LAS float* wsf = (LAS float*)(lds + LDS_WSF) + wave * 32;
    if (hi == 0) wsf[qp] = __builtin_amdgcn_rcpf(l);
    f32x16 O[2];
#pragma unroll
    for (int r = 0; r < 16; ++r) { O[0][r] = 0.f; O[1][r] = 0.f; }
#pragma unroll
    for (int kt = 0; kt < 5; ++kt) {
        const bool tv = !(blk == 0 && wave + kt < 4);
        if (tv) {
#pragma unroll
            for (int kb2 = 0; kb2 < 2; ++kb2) {
                u32x4 pw; pw.x = cvt_pk_bf16(S[kt][8 * kb2 + 0], S[kt][8 * kb2 + 1]); pw.y = cvt_pk_bf16(S[kt][8 * kb2 + 2], S[kt][8 * kb2 + 3]);
                pw.z = cvt_pk_bf16(S[kt][8 * kb2 + 4], S[kt][8 * kb2 + 5]); pw.w = cvt_pk_bf16(S[kt][8 * kb2 + 6], S[kt][8 * kb2 + 7]);
                const bf16x8 pa = __builtin_bit_cast(bf16x8, pw);
#pragma unroll
                for (int nt = 0; nt < 2; ++nt) {
                    const LAS unsigned char* vp = lds + LDS_VT + (32 * nt + qp) * VT_PITCH + 2 * (32 * wave + 32 * kt + 16 * kb2 + 4 * hi);
                    const u32x2 lo = *(const LAS u32x2*)vp, hi2 = *(const LAS u32x2*)(vp + 16);
                    u32x4 vw; vw.x = lo.x; vw.y = lo.y; vw.z = hi2.x; vw.w = hi2.y;
                    O[nt] = __builtin_amdgcn_mfma_f32_32x32x16_bf16(pa, __builtin_bit_cast(bf16x8, vw), O[nt], 0, 0, 0);
                }
            }
        }
    }
    LDS_WAIT();
    bf16* og = Og + ((size_t)g * R + (size_t)b * SEQ) * 512 + h * 64 + qp;
#pragma unroll
    for (int r = 0; r < 16; ++r) { const int ql = (r & 3) + 8 * (r >> 2) + 4 * hi; const float li = wsf[ql];
        const size_t tok = (size_t)((256 * blk + 32 * wave + ql) * d + res);
        const unsigned w0 = cvt_pk_bf16(O[0][r] * li, O[1][r] * li);
        og[tok * 512] = (bf16)(w0 & 0xffffu); og[tok * 512 + 32] = (bf16)(w0 >> 16); }
    if (hi == 0) Lse[((size_t)g * R + (size_t)b * SEQ + (size_t)(iq * d + res)) * 8 + h] = (mx + __builtin_amdgcn_logf(l)) * LN2;
}

__device__ __forceinline__ float red8(float v) {
    v += __builtin_bit_cast(float, __builtin_amdgcn_update_dpp(0, __builtin_bit_cast(int, v), 0xB1, 0xF, 0xF, true));
    v += __builtin_bit_cast(float, __builtin_amdgcn_update_dpp(0, __builtin_bit_cast(int, v), 0x4E, 0xF, 0xF, true));
    v += __builtin_bit_cast(float, __builtin_amdgcn_update_dpp(0, __builtin_bit_cast(int, v), 0x141, 0xF, 0xF, true));
    return v;
}
__device__ __forceinline__ void sattn_task(const Args& a, const bf16* Hs, float* Sp, int task, int lane) {
    const int chunk = task & 7, bt = task >> 3, t = bt & 7, bg = bt >> 3, g = bg % 3, b = bg / 3;
    const int d = (g == 0) ? 1 : (g == 1) ? 4 : 16, wb = 128 * d;
    const float* cache = (g == 0) ? a.c0 : (g == 1) ? a.c1 : a.c2;
    const int j0 = (chunk == 0) ? 0 : 17 + 16 * (chunk - 1), j1 = 17 + 16 * chunk;
    const int h = lane >> 3;
    const float sl = __builtin_amdgcn_exp2f(-(float)(h + 1)) * LOG2E * (float)d;
    float q[8];
    { const u32x4 qv = *(const u32x4*)(Hs + (size_t)(b * 8 + t) * HSP + HS_Q + g * 512 + lane * 8);
      q[0] = bf_lo(qv.x); q[1] = bf_hi(qv.x); q[2] = bf_lo(qv.y); q[3] = bf_hi(qv.y); q[4] = bf_lo(qv.z); q[5] = bf_hi(qv.z); q[6] = bf_lo(qv.w); q[7] = bf_hi(qv.w); }
    float m = -INFINITY, l = 0.f, o[8];
#pragma unroll
    for (int i = 0; i < 8; ++i) o[i] = 0.f;
    int j = j0;
#define SATTN_STEP(kv, vv, jj) do { float s_ = 0.f; _Pragma("unroll") for (int i_ = 0; i_ < 8; ++i_) s_ += q[i_] * kv[i_]; \
        s_ = red8(s_); s_ -= sl * (float)(jj); \
        const float mn_ = fmaxf(m, s_), f_ = __builtin_amdgcn_exp2f(m - mn_), p_ = __builtin_amdgcn_exp2f(s_ - mn_); l = l * f_ + p_; \
        _Pragma("unroll") for (int i_ = 0; i_ < 8; ++i_) o[i_] = o[i_] * f_ + p_ * vv[i_]; m = mn_; } while (0)
    for (; j < j1 && t - j * d >= 0; ++j) {
        const bf16* rp = Hs + (size_t)(b * 8 + t - j * d) * HSP + g * 512 + lane * 8;
        const u32x4 kv4 = *(const u32x4*)(rp + HS_K), vv4 = *(const u32x4*)(rp + HS_V);
        float kf[8], vf[8];
        kf[0] = bf_lo(kv4.x); kf[1] = bf_hi(kv4.x); kf[2] = bf_lo(kv4.y); kf[3] = bf_hi(kv4.y); kf[4] = bf_lo(kv4.z); kf[5] = bf_hi(kv4.z); kf[6] = bf_lo(kv4.w); kf[7] = bf_hi(kv4.w);
        vf[0] = bf_lo(vv4.x); vf[1] = bf_hi(vv4.x); vf[2] = bf_lo(vv4.y); vf[3] = bf_hi(vv4.y); vf[4] = bf_lo(vv4.z); vf[5] = bf_hi(vv4.z); vf[6] = bf_lo(vv4.w); vf[7] = bf_hi(vv4.w);
        SATTN_STEP(kf, vf, j);
    }
    const float* cb = cache + (size_t)b * wb * 1024 + lane * 8;
#pragma unroll 4
    for (; j < j1; ++j) {
        const float* rp = cb + (size_t)(wb + t - j * d) * 1024;
        const f32x4 k0 = *(const f32x4*)rp, k1 = *(const f32x4*)(rp + 4), v0 = *(const f32x4*)(rp + 512), v1 = *(const f32x4*)(rp + 516);
        float kf[8] = {k0.x, k0.y, k0.z, k0.w, k1.x, k1.y, k1.z, k1.w}, vf[8] = {v0.x, v0.y, v0.z, v0.w, v1.x, v1.y, v1.z, v1.w};
        SATTN_STEP(kf, vf, j);
    }
#undef SATTN_STEP
    float* sp = Sp + (size_t)task * 640 + lane;
    sp[0] = m; sp[64] = l;
#pragma unroll
    for (int i = 0; i < 8; ++i) sp[128 + 64 * i] = o[i];
}

template <int RR> struct ConvRows {
    static __device__ __forceinline__ void run(f32x2 (&acc)[16], const f32x2 (&w)[31], const LAS unsigned char* p) {
        const unsigned uu = *(const LAS unsigned*)(p + RR * 2048); const f32x2 u = (f32x2){bf_lo(uu), bf_hi(uu)};
        constexpr int JLO = RR > 15 ? RR - 15 : 0, JHI = RR < 30 ? RR : 30;
#pragma unroll
        for (int j = JLO; j <= JHI; ++j) acc[RR - j] += u * w[j];
        if ((RR & 7) == 7) asm volatile("" ::: "memory");
        ConvRows<RR + 1>::run(acc, w, p);
    }
};
template <> struct ConvRows<46> { static __device__ __forceinline__ void run(f32x2 (&)[16], const f32x2 (&)[31], const LAS unsigned char*) {} };
constexpr int LDS_RED = 62 * 2048  , LDS_STAT = LDS_RED + 2048;
__device__ __forceinline__ void conv_tile(const Args& a, LAS unsigned char* lds, const bf16* Ub, const bf16* ZAb, bf16* CA, int tile, int tid, int lane, int wave,
                                          float cb0, float cb1, float lg0, float lg1, float lbb0, float lbb1) {
    const bool samp = tile >= 1024; const int b = samp ? tile - 1024 : tile >> 7, tt = tile & 127, t0 = 32 * tt;
    const int ntok = samp ? 8 : 32;
    const size_t rowbase = samp ? (size_t)(RP + b * 8) : (size_t)b * SEQ + t0;
#pragma unroll 4
    for (int i = 0; i < 16; ++i) { const int c = tid + NT * i; if (c < 62 * 128) { const int rr = c >> 7, ch = c & 127;
        u32x4 v = (u32x4){0u, 0u, 0u, 0u};
        if (!samp) { const int t = t0 - 30 + rr; if (t >= 0) v = *(const u32x4*)(Ub + ((size_t)b * SEQ + t) * 1024 + ch * 8); }
        else if (rr < 30) { const f32x4* sp = (const f32x4*)(a.sconv + ((size_t)b * 30 + rr) * 1024 + ch * 8); const f32x4 x0 = sp[0], x1 = sp[1];
            v.x = cvt_pk_bf16(x0.x, x0.y); v.y = cvt_pk_bf16(x0.z, x0.w); v.z = cvt_pk_bf16(x1.x, x1.y); v.w = cvt_pk_bf16(x1.z, x1.w); }
        else if (rr < 38) v = *(const u32x4*)(Ub + (size_t)(RP + b * 8 + rr - 30) * 1024 + ch * 8);
        *(LAS u32x4*)(lds + rr * 2048 + ch * 16) = v; } }
    f32x2 w[31];
#pragma unroll
    for (int j = 0; j < 31; ++j) w[j] = *(const f32x2*)(a.conv_w + j * 1024 + 2 * tid);
    __syncthreads();
    if (!samp && tt == 127) {
        float* cp = a.out + O_CONVP + (size_t)b * 30 * 1024 + 2 * tid;
#pragma unroll 6
        for (int k = 0; k < 30; ++k) { const unsigned uu = *(const LAS unsigned*)(lds + (32 + k) * 2048 + tid * 4); *(f32x2*)(cp + (size_t)k * 1024) = (f32x2){bf_lo(uu), bf_hi(uu)}; }
    }
    if (samp) {
        float* cp = a.out + O_CONVS + (size_t)b * 30 * 1024 + 2 * tid;
        for (int k = 0; k < 22; ++k) *(f32x2*)(cp + (size_t)k * 1024) = *(const f32x2*)(a.sconv + ((size_t)b * 30 + k + 8) * 1024 + 2 * tid);
        for (int k = 22; k < 30; ++k) { const unsigned uu = *(const LAS unsigned*)(lds + (30 + k - 22) * 2048 + tid * 4); *(f32x2*)(cp + (size_t)k * 1024) = (f32x2){bf_lo(uu), bf_hi(uu)}; }
    }
    LAS float* red = (LAS float*)(lds + LDS_RED); LAS f32x2* stat = (LAS f32x2*)(lds + LDS_STAT);
    const int nhalf = samp ? 1 : 2;
    for (int half = 0; half < nhalf; ++half) {
        f32x2 acc[16];
#pragma unroll
        for (int i = 0; i < 16; ++i) acc[i] = (f32x2){cb0, cb1};
        const bf16* zap = ZAb + (rowbase + half * 16) * 1024 + 2 * tid;
        unsigned zav[16];
#pragma unroll
        for (int to = 0; to < 16; ++to) zav[to] = (to < ntok) ? *(const unsigned*)(zap + (size_t)to * 1024) : 0u;
        ConvRows<0>::run(acc, w, lds + half * 16 * 2048 + tid * 4);
        asm volatile("" ::: "memory");
        float tot;
        { float vals[32];
#pragma unroll
          for (int i = 0; i < 16; ++i) { vals[i] = acc[i].x + acc[i].y; vals[16 + i] = acc[i].x * acc[i].x + acc[i].y * acc[i].y; }
#define BFLY(off) do { const bool up_ = (lane & (off)) != 0; _Pragma("unroll") for (int i_ = 0; i_ < (off); ++i_) { const float lo_ = vals[i_], hi_ = vals[i_ + (off)]; \
        const float send_ = up_ ? lo_ : hi_, keep_ = up_ ? hi_ : lo_; vals[i_] = keep_ + __shfl_xor(send_, (off)); } } while (0)
          BFLY(16); BFLY(8); BFLY(4); BFLY(2); BFLY(1);
#undef BFLY
          tot = vals[0] + __shfl_xor(vals[0], 32); }
        if (lane < 32) red[wave * 32 + lane] = tot;
        __syncthreads();
        if (tid < 16) { float s1 = 0.f, s2 = 0.f;
#pragma unroll
            for (int wv = 0; wv < 8; ++wv) { s1 += red[wv * 32 + tid]; s2 += red[wv * 32 + 16 + tid]; }
            const float mean = s1 * (1.f / 1024.f), var = fmaxf(s2 * (1.f / 1024.f) - mean * mean, 0.f);
            stat[tid] = (f32x2){mean, 1.0f / sqrtf(var + LN_EPS)}; }
        __syncthreads();
        bf16* op = CA + (rowbase + half * 16) * 1024 + 2 * tid;
#pragma unroll
        for (int to = 0; to < 16; ++to) { if (to < ntok) { const f32x2 st = stat[to]; const unsigned za = zav[to];
            const float y0 = (acc[to].x - st.x) * st.y * lg0 + lbb0, y1 = (acc[to].y - st.x) * st.y * lg1 + lbb1;
            const float z0 = bf_lo(za), z1 = bf_hi(za);
            *(unsigned*)(op + (size_t)to * 1024) = cvt_pk_bf16(y0 * sigm(y0) * (z0 * sigm(z0)), y1 * sigm(y1) * (z1 * sigm(z1))); }
            if ((to & 7) == 7) asm volatile("" ::: "memory"); }
    }
    __syncthreads();
}

__device__ __forceinline__ void combine_row(const bf16* Hb, const bf16* Og, const float* Lse, const float* Sp, bf16* AB, int row, int lane) {
    const int h = lane >> 3;
    float og[3][8], ls[3];
    if (row < RP) {
#pragma unroll
        for (int g = 0; g < 3; ++g) { ls[g] = Lse[((size_t)g * R + row) * 8 + h]; const u32x4 v = *(const u32x4*)(Og + ((size_t)g * R + row) * 512 + lane * 8);
            og[g][0] = bf_lo(v.x); og[g][1] = bf_hi(v.x); og[g][2] = bf_lo(v.y); og[g][3] = bf_hi(v.y); og[g][4] = bf_lo(v.z); og[g][5] = bf_hi(v.z); og[g][6] = bf_lo(v.w); og[g][7] = bf_hi(v.w); }
    } else {
        const int sr = row - RP, b = sr >> 3, t = sr & 7;
#pragma unroll
        for (int g = 0; g < 3; ++g) { const float* sp = Sp + (size_t)((((b * 3 + g) * 8 + t) * 8)) * 640 + lane;
            float mc[8], M = -INFINITY;
#pragma unroll
            for (int c = 0; c < 8; ++c) { mc[c] = sp[c * 640]; M = fmaxf(M, mc[c]); }
            float L = 0.f, oo[8];
#pragma unroll
            for (int i = 0; i < 8; ++i) oo[i] = 0.f;
#pragma unroll
            for (int c = 0; c < 8; ++c) { const float f = __builtin_amdgcn_exp2f(mc[c] - M); L += sp[c * 640 + 64] * f;
#pragma unroll
                for (int i = 0; i < 8; ++i) oo[i] += sp[c * 640 + 128 + 64 * i] * f; }
            const float li = 1.0f / L;
#pragma unroll
            for (int i = 0; i < 8; ++i) og[g][i] = oo[i] * li;
            ls[g] = (M + __builtin_amdgcn_logf(L)) * LN2; }
    }
    const float mx = fmaxf(ls[0], fmaxf(ls[1], ls[2]));
    const float e0 = __expf(ls[0] - mx), e1 = __expf(ls[1] - mx), e2 = __expf(ls[2] - mx), inv = 1.0f / (e0 + e1 + e2);
    const float w0 = e0 * inv, w1 = e1 * inv, w2 = e2 * inv;
    const u32x4 z = *(const u32x4*)(Hb + (size_t)row * HP + HC_ZB + lane * 8);
    float r[8];
#pragma unroll
    for (int i = 0; i < 8; ++i) r[i] = w0 * og[0][i] + w1 * og[1][i] + w2 * og[2][i];
#define SILU_(v) ((v) * sigm(v))
    u32x4 o; o.x = cvt_pk_bf16(r[0] * SILU_(bf_lo(z.x)), r[1] * SILU_(bf_hi(z.x))); o.y = cvt_pk_bf16(r[2] * SILU_(bf_lo(z.y)), r[3] * SILU_(bf_hi(z.y)));
    o.z = cvt_pk_bf16(r[4] * SILU_(bf_lo(z.z)), r[5] * SILU_(bf_hi(z.z))); o.w = cvt_pk_bf16(r[6] * SILU_(bf_lo(z.w)), r[7] * SILU_(bf_hi(z.w)));
#undef SILU_
    *(u32x4*)(AB + (size_t)row * 512 + lane * 8) = o;
}

constexpr int NTAIL = 4;
__device__ __forceinline__ void kv_outputs(const Args& a, const bf16* Hs, const bf16* QKVh, int g_lo, int g_hi, int gtid, int gthreads) {
    for (int g = g_lo; g < g_hi; ++g) {
        const int keep = 128 << (2 * g), lg = 2 * g; const size_t nch = (size_t)8 * keep * 128;
        float* dst = a.out + (g == 0 ? O_KVP0 : g == 1 ? O_KVP1 : O_KVP2);
        for (size_t j = gtid; j < nch; j += gthreads) {
            const int c = (int)(j & 127), kv = c >> 6, cc = c & 63; const size_t bi = j >> 7; const int ii = (int)(bi % keep), b = (int)(bi / keep);
            const int t = SEQ - keep + ii, ti = ((t & ((1 << lg) - 1)) << (12 - lg)) + (t >> lg), hh = cc >> 3;
            const u32x4 v = *(const u32x4*)(QKVh + ((size_t)(((((kv + 1) * 8 + b) * 3 + g) * 8 + hh) * 4096 + ti)) * 64 + (cc & 7) * 8);
            f32x4* dp = (f32x4*)(dst + j * 8);
            dp[0] = (f32x4){bf_lo(v.x), bf_hi(v.x), bf_lo(v.y), bf_hi(v.y)}; dp[1] = (f32x4){bf_lo(v.z), bf_hi(v.z), bf_lo(v.w), bf_hi(v.w)};
        }
    }
    if (g_lo == 0) {
        for (int i = gtid; i < 32 * 3 * 8 * 128; i += gthreads) {
            const int c = i & 127, kv = c >> 6, cc = c & 63, t = (i >> 7) & 7, bg = i >> 10, g = bg % 3, b = bg / 3;
            const int wb = 128 << (2 * g);
            float* dst = a.out + (g == 0 ? O_KVS0 : g == 1 ? O_KVS1 : O_KVS2) + ((size_t)b * wb + wb - 8 + t) * 1024 + (size_t)c * 8;
            const u32x4 v = *(const u32x4*)(Hs + (size_t)(b * 8 + t) * HSP + (kv ? HS_V : HS_K) + g * 512 + cc * 8);
            ((f32x4*)dst)[0] = (f32x4){bf_lo(v.x), bf_hi(v.x), bf_lo(v.y), bf_hi(v.y)}; ((f32x4*)dst)[1] = (f32x4){bf_lo(v.z), bf_hi(v.z), bf_lo(v.w), bf_hi(v.w)};
        }
    }
}

__device__ __forceinline__ void combine_prompt4(const bf16* Hb, const bf16* Og, const float* Lse, bf16* AB, int row0, int lane) {
    const int h = lane >> 3;
    u32x4 ov[4][3], zv[4]; float ls[4][3];
#pragma unroll
    for (int k = 0; k < 4; ++k) { const size_t row = (size_t)(row0 + k);
#pragma unroll
        for (int g = 0; g < 3; ++g) { ls[k][g] = Lse[((size_t)g * R + row) * 8 + h]; ov[k][g] = *(const u32x4*)(Og + ((size_t)g * R + row) * 512 + lane * 8); }
        zv[k] = *(const u32x4*)(Hb + row * HP + HC_ZB + lane * 8); }
#pragma unroll
    for (int k = 0; k < 4; ++k) {
        const float mx = fmaxf(ls[k][0], fmaxf(ls[k][1], ls[k][2]));
        const float e0 = __expf(ls[k][0] - mx), e1 = __expf(ls[k][1] - mx), e2 = __expf(ls[k][2] - mx), inv = 1.0f / (e0 + e1 + e2);
        const float w0 = e0 * inv, w1 = e1 * inv, w2 = e2 * inv;
        const u32x4 a = ov[k][0], b = ov[k][1], c = ov[k][2], z = zv[k];
        u32x4 o;
        { const float zl = bf_lo(z.x), zh = bf_hi(z.x); o.x = cvt_pk_bf16((w0 * bf_lo(a.x) + w1 * bf_lo(b.x) + w2 * bf_lo(c.x)) * (zl * sigm(zl)), (w0 * bf_hi(a.x) + w1 * bf_hi(b.x) + w2 * bf_hi(c.x)) * (zh * sigm(zh))); }
        { const float zl = bf_lo(z.y), zh = bf_hi(z.y); o.y = cvt_pk_bf16((w0 * bf_lo(a.y) + w1 * bf_lo(b.y) + w2 * bf_lo(c.y)) * (zl * sigm(zl)), (w0 * bf_hi(a.y) + w1 * bf_hi(b.y) + w2 * bf_hi(c.y)) * (zh * sigm(zh))); }
        { const float zl = bf_lo(z.z), zh = bf_hi(z.z); o.z = cvt_pk_bf16((w0 * bf_lo(a.z) + w1 * bf_lo(b.z) + w2 * bf_lo(c.z)) * (zl * sigm(zl)), (w0 * bf_hi(a.z) + w1 * bf_hi(b.z) + w2 * bf_hi(c.z)) * (zh * sigm(zh))); }
        { const float zl = bf_lo(z.w), zh = bf_hi(z.w); o.w = cvt_pk_bf16((w0 * bf_lo(a.w) + w1 * bf_lo(b.w) + w2 * bf_lo(c.w)) * (zl * sigm(zl)), (w0 * bf_hi(a.w) + w1 * bf_hi(b.w) + w2 * bf_hi(c.w)) * (zh * sigm(zh))); }
        *(u32x4*)(AB + (size_t)(row0 + k) * 512 + lane * 8) = o;
    }
}

__device__ __forceinline__ float wave_sum(float v) {
#pragma unroll
    for (int o = 1; o < 64; o <<= 1) v += __shfl_xor(v, o);
    return v;
}

#define RLX_AGENT __ATOMIC_RELAXED, __HIP_MEMORY_SCOPE_AGENT
#define XB_TMO      128
#define XB_XCNT(j)  (256  + 64 * (j))
#define XB_XSUB(j)  (1280 + 64 * (j))
#define XB_XGEN(j)  (2304 + 64 * (j))
#define XB_TOP      3328
#define XB_TOPGEN   3392
#define XCD_BAR_WORDS 3456
#define XB_SPIN_CAP (1u << 18)

__device__ __forceinline__ unsigned xb_ld(unsigned* p)              { return __hip_atomic_load(p, __ATOMIC_RELAXED, __HIP_MEMORY_SCOPE_AGENT); }
__device__ __forceinline__ unsigned xb_add(unsigned* p, unsigned v) { return __hip_atomic_fetch_add(p, v, __ATOMIC_RELAXED, __HIP_MEMORY_SCOPE_AGENT); }
__device__ __forceinline__ unsigned xb_xcc_id() { return (unsigned)__builtin_amdgcn_s_getreg((3 << 11) | 20) & 0xFu; }
#define XB_SPIN(cond, bar) do { unsigned _sp = 0; while (cond) { __builtin_amdgcn_s_sleep(1); \
    if ((++_sp & 255u) == 0u) { if (xb_ld(&(bar)[XB_TMO])) break; if (_sp > XB_SPIN_CAP) { atomicAdd(&(bar)[XB_TMO], 1u); break; } } } } while (0)

struct XcdBarrier {
    unsigned* bar; unsigned x;
    volatile LAS unsigned* st;
};

__device__ __forceinline__ XcdBarrier xcd_barrier_post(unsigned* bar, volatile LAS unsigned* st) {
    XcdBarrier b; b.bar = bar; b.x = xb_xcc_id(); b.st = st;
    if (threadIdx.x == 0) (void)xb_add(&bar[XB_XCNT(b.x)], 1u);
    return b;
}
__device__ __forceinline__ void xcd_barrier_complete(unsigned* bar, unsigned x, unsigned& nloc, unsigned& nx) {
    const unsigned G = gridDim.x * gridDim.y * gridDim.z;
    unsigned sum, cnt, mine, sp = 0u;
    for (;;) {
        sum = 0u; cnt = 0u; mine = 0u;
#pragma unroll
        for (unsigned j = 0; j < 16; ++j) { const unsigned c = xb_ld(&bar[XB_XCNT(j)]); sum += c; cnt += (c > 0u) ? 1u : 0u; mine = (j == x) ? c : mine; }
        if (sum == G) break;
        __builtin_amdgcn_s_sleep(1);
        if ((++sp & 255u) == 0u) { if (xb_ld(&bar[XB_TMO])) break; if (sp > XB_SPIN_CAP) { atomicAdd(&bar[XB_TMO], 1u); break; } }
    }
    nloc = mine > 0u ? mine : 1u; nx = cnt > 0u ? cnt : 1u;
}

__device__ __forceinline__ void xcd_barrier(const XcdBarrier& b) {
    asm volatile("s_waitcnt vmcnt(0)" ::: "memory");
    __syncthreads();
    if (threadIdx.x == 0) {
        unsigned* bar = b.bar;
        __builtin_amdgcn_s_waitcnt(0);
        unsigned nloc = b.st[0], nx = b.st[1];
        if (nloc == 0u) { xcd_barrier_complete(bar, b.x, nloc, nx); b.st[0] = nloc; b.st[1] = nx; }
        const unsigned old = xb_add(&bar[XB_XSUB(b.x)], 1u);
        const unsigned gen = old / nloc;
        if (old + 1u == (gen + 1u) * nloc) {
            __builtin_amdgcn_fence(__ATOMIC_RELEASE, "agent");
            asm volatile("s_waitcnt vmcnt(0)" ::: "memory");
            const unsigned og = xb_add(&bar[XB_TOP], 1u);
            const unsigned tg = og / nx;
            if (og + 1u == (tg + 1u) * nx) xb_add(&bar[XB_TOPGEN], 1u);
            else XB_SPIN(xb_ld(&bar[XB_TOPGEN]) == tg, bar);
            __builtin_amdgcn_fence(__ATOMIC_ACQUIRE, "agent");
            xb_add(&bar[XB_XGEN(b.x)], 1u);
            asm volatile("s_waitcnt vmcnt(0)" ::: "memory");
        } else {
            XB_SPIN(xb_ld(&bar[XB_XGEN(b.x)]) == gen, bar);
            __builtin_amdgcn_fence(__ATOMIC_ACQUIRE, "agent");
            asm volatile("s_waitcnt vmcnt(0)" ::: "memory");
        }
    }
    __syncthreads();
}

__device__ __forceinline__ int fresh_tid() { int t; asm volatile("v_mov_b32 %0, %1" : "=v"(t) : "v"((int)threadIdx.x)); return t; }
#define FRESH_IDS() const int tid = fresh_tid(), lane = tid & 63, wave = __builtin_amdgcn_readfirstlane(tid >> 6)
__global__ void __launch_bounds__(NT, 2) fwd_mega(Args a) {
    extern __shared__ __attribute__((aligned(16))) unsigned char lds_raw[];
    cg::grid_group grid = cg::this_grid();
    LAS unsigned char* lds = (LAS unsigned char*)lds_raw;
    const int G = gridDim.x;
    if (threadIdx.x < 16) ((LAS unsigned*)(lds + LDS_MISC))[threadIdx.x] = 0u;
    unsigned* barw = (unsigned*)(a.ws + WS_BAR);
    if (blockIdx.x == 0) for (int i = threadIdx.x; i < XCD_BAR_WORDS; i += NT) barw[i] = 0u;
    __syncthreads();
    unsigned char* ws = a.ws;
    bf16* WinT = (bf16*)(ws + WS_WIN); bf16* WaT = (bf16*)(ws + WS_WA); bf16* WbT = (bf16*)(ws + WS_WB); bf16* WoT = (bf16*)(ws + WS_WO); float* bp = (float*)(ws + WS_BP); bf16* Xb = (bf16*)(ws + WS_XB);
    bf16* CA = (bf16*)(ws + WS_CA); bf16* AB = (bf16*)(ws + WS_AB); bf16* Mb = (bf16*)(ws + WS_MB); bf16* Og = (bf16*)(ws + WS_OG); float* Lse = (float*)(ws + WS_LSE); float* Sp = (float*)(ws + WS_SP); bf16* Hb = (bf16*)(ws + WS_HB); bf16* Hs = (bf16*)(ws + WS_HS); bf16* Ub = (bf16*)(ws + WS_U); bf16* ZAb = (bf16*)(ws + WS_ZA); bf16* QKVh = (bf16*)(ws + WS_QKV); bf16* Ypre = (bf16*)(ws + WS_Y);

    for (int rep = 0; rep < REP_P0; ++rep) { FRESH_IDS(); phase0(a, lds, tid, lane, wave, G);
    grid.sync(); }
    XcdBarrier xbar = xcd_barrier_post(barw, (volatile LAS unsigned*)(lds + LDS_MISC) + 8);

    for (int i = 0; i < REP_SYNC; ++i) xcd_barrier(xbar);
    for (int rep = 0; rep < REP_P1; ++rep) {
    { pg8::Gemm g{Xb, WinT, R, INW, D}; pg8::StaticOrder S; S.init(R, INW, G, (int)blockIdx.x);
      pg8::EpiIn E{Hb, Hs, Ub, ZAb, QKVh, bp, QS, a.c0, a.c1, a.c2, a.out + O_KVS0, a.out + O_KVS1, a.out + O_KVS2};
      pg8::gemm_phase<pg8::EpiIn, pg8::StaticOrder, true, true>(lds, g, S, E); }
    xcd_barrier(xbar); }

    { FRESH_IDS();
    AttnPre pre; int u = blockIdx.x;
    if (u < 3072 * REP_ATT) attn_load(QKVh, u % 3072, tid, lane, wave, pre);
    for (; u < 3072 * REP_ATT; u += G) {
        attn_stage(lds, pre, tid);
        bf16x8 qf[4];
#pragma unroll
        for (int kd = 0; kd < 4; ++kd) qf[kd] = pre.q[kd];
        __syncthreads();
        if (u + G < 3072 * REP_ATT) attn_load(QKVh, (u + G) % 3072, tid, lane, wave, pre);
        attn_compute(lds, qf, Og, Lse, u % 3072, tid, lane, wave);
        __syncthreads();
    } }
    { FRESH_IDS();
    for (int u = blockIdx.x; u < 768 * REP_SATT; u += G) sattn_task(a, Hs, Sp, (u % 768) * 8 + wave, lane); }
    { FRESH_IDS();
        const f32x2 cbv = *(const f32x2*)(a.conv_b + 2 * tid), lgv = *(const f32x2*)(a.cln_g + 2 * tid), lbv = *(const f32x2*)(a.cln_b + 2 * tid);
        for (int u = blockIdx.x; u < 1056 * REP_CONV; u += G) conv_tile(a, lds, Ub, ZAb, CA, u % 1056, tid, lane, wave, cbv.x, cbv.y, lgv.x, lgv.y, lbv.x, lbv.y);
    }
    xcd_barrier(xbar);

#define P3_BODY \
    { FRESH_IDS(); const int gw = blockIdx.x * NWAVES + wave; for (int q = gw; q < RP / 4; q += G * NWAVES) combine_prompt4(Hb, Og, Lse, AB, 4 * q, lane); \
      if (gw < RS) combine_row(Hb, Og, Lse, Sp, AB, RP + gw, lane); } \
    { pg8::Gemm g{CA, WaT, R, D, D}; pg8::StaticOrder S; S.init(R, D, G, (int)blockIdx.x); \
      pg8::EpiGate<false> E{Hb, Mb, HC_GA}; \
      pg8::gemm_phase<pg8::EpiGate<false>, pg8::StaticOrder, true, true>(lds, g, S, E); } \
    xcd_barrier(xbar); \
    { pg8::Gemm g{AB, WbT, R, D, 512}; pg8::StaticOrder S; S.init(R, D, G, (int)blockIdx.x); \
      pg8::EpiGate<true> E{Hb, Mb, HC_GB}; \
      pg8::gemm_phase<pg8::EpiGate<true>, pg8::StaticOrder, true, true>(lds, g, S, E); } \
    if (blockIdx.x >= NTAIL) { FRESH_IDS(); kv_outputs(a, Hs, QKVh, 0, 2, (blockIdx.x - NTAIL) * NT + tid, (G - NTAIL) * NT); } \
    xcd_barrier(xbar);
    P3_BODY
#if REP_P3 > 1
    P3_BODY
#endif
#undef P3_BODY

    for (int rep = 0; rep < REP_P4; ++rep) {
    { pg8::Gemm g{Mb, WoT, R, D, D}; pg8::StaticOrder S; S.init(R, D, G, (int)blockIdx.x);
      pg8::EpiOut E{a.xp, a.xs, Ypre, ALPHA, RP};
      pg8::gemm_phase<pg8::EpiOut, pg8::StaticOrder, true, true>(lds, g, S, E); }
    if (blockIdx.x >= NTAIL) { FRESH_IDS(); kv_outputs(a, Hs, QKVh, 2, 3, (blockIdx.x - NTAIL) * NT + tid, (G - NTAIL) * NT); }
    xcd_barrier(xbar); }

    for (int rep = 0; rep < REP_P5; ++rep) { FRESH_IDS();
        f32x4 gv[4], bv[4];
#pragma unroll
        for (int j = 0; j < 2; ++j) { gv[2 * j] = *(const f32x4*)(a.ln_g + 512 * j + 8 * lane); gv[2 * j + 1] = *(const f32x4*)(a.ln_g + 512 * j + 8 * lane + 4);
            bv[2 * j] = *(const f32x4*)(a.ln_b + 512 * j + 8 * lane); bv[2 * j + 1] = *(const f32x4*)(a.ln_b + 512 * j + 8 * lane + 4); }
        for (int q = blockIdx.x * NWAVES + wave; q < R / 4; q += G * NWAVES) {
            u32x4 raw[4][2]; f32x4 v[4][4]; float s[4], s2[4];
#pragma unroll
            for (int k = 0; k < 4; ++k)
#pragma unroll
                for (int j = 0; j < 2; ++j) raw[k][j] = *(const u32x4*)(Ypre + (size_t)(4 * q + k) * D + 512 * j + 8 * lane);
#pragma unroll
            for (int k = 0; k < 4; ++k) { s[k] = 0.f;
#pragma unroll
                for (int j = 0; j < 2; ++j) { const u32x4 r = raw[k][j]; v[k][2 * j] = (f32x4){bf_lo(r.x), bf_hi(r.x), bf_lo(r.y), bf_hi(r.y)}; v[k][2 * j + 1] = (f32x4){bf_lo(r.z), bf_hi(r.z), bf_lo(r.w), bf_hi(r.w)}; }
#pragma unroll
                for (int j = 0; j < 4; ++j) s[k] += (v[k][j].x + v[k][j].y) + (v[k][j].z + v[k][j].w); }
#pragma unroll
            for (int o = 1; o < 64; o <<= 1) {
#pragma unroll
                for (int k = 0; k < 4; ++k) s[k] += __shfl_xor(s[k], o); }
#pragma unroll
            for (int k = 0; k < 4; ++k) { const float mean = s[k] * (1.f / D); s2[k] = 0.f;
#pragma unroll
                for (int j = 0; j < 4; ++j) { v[k][j] = v[k][j] - mean; s2[k] += (v[k][j].x * v[k][j].x + v[k][j].y * v[k][j].y) + (v[k][j].z * v[k][j].z + v[k][j].w * v[k][j].w); } }
#pragma unroll
            for (int o = 1; o < 64; o <<= 1) {
#pragma unroll
                for (int k = 0; k < 4; ++k) s2[k] += __shfl_xor(s2[k], o); }
#pragma unroll
            for (int k = 0; k < 4; ++k) { const float rstd = 1.f / sqrtf(s2[k] * (1.f / D) + LN_EPS); float* yr = a.out + (size_t)(4 * q + k) * D + 8 * lane;
#pragma unroll
                for (int j = 0; j < 4; ++j) *(f32x4*)(yr + 512 * (j >> 1) + 4 * (j & 1)) = v[k][j] * rstd * gv[j] + bv[j]; }
        }
    }
}

extern "C" void kernel_launch(void* const* d_in, const int* in_sizes, int n_in, void* d_out, int out_size, void* d_ws, size_t ws_size, hipStream_t stream) {
    static int grid = 0;
    if (grid == 0) {
        if (n_in != 17 || out_size != 145145856 || ws_size < WS_END) { fprintf(stderr, "kernel_launch: unexpected problem shape / workspace (n_in %d out %d ws %zu)\n", n_in, out_size, ws_size); grid = -1; return; }
        int dev = 0, cus = 0, per_cu = 0;
        if (hipGetDevice(&dev) != hipSuccess || hipDeviceGetAttribute(&cus, hipDeviceAttributeMultiprocessorCount, dev) != hipSuccess) { grid = -1; return; }
        if (hipFuncSetAttribute((const void*)fwd_mega, hipFuncAttributeMaxDynamicSharedMemorySize, LDS_BYTES) != hipSuccess) { grid = -1; return; }
        if (hipOccupancyMaxActiveBlocksPerMultiprocessor(&per_cu, (const void*)fwd_mega, NT, LDS_BYTES) != hipSuccess || per_cu < 1) { fprintf(stderr, "kernel_launch: occupancy query gave %d\n", per_cu); grid = -1; return; }
        grid = cus * 1;
    }
    if (grid < 0) return;
    Args a{};
    a.xp = (const float*)d_in[0]; a.xs = (const float*)d_in[1]; a.c0 = (const float*)d_in[2]; a.c1 = (const float*)d_in[3]; a.c2 = (const float*)d_in[4]; a.sconv = (const float*)d_in[5];
    a.w_in = (const float*)d_in[6]; a.b_in = (const float*)d_in[7]; a.conv_w = (const float*)d_in[8]; a.conv_b = (const float*)d_in[9]; a.cln_g = (const float*)d_in[10]; a.cln_b = (const float*)d_in[11];
    a.w_a = (const float*)d_in[12]; a.w_b = (const float*)d_in[13]; a.w_out = (const float*)d_in[14]; a.ln_g = (const float*)d_in[15]; a.ln_b = (const float*)d_in[16];
    a.out = (float*)d_out; a.ws = (unsigned char*)d_ws;
    void* args[] = {&a};
    hipError_t e = hipLaunchCooperativeKernel((const void*)fwd_mega, dim3(grid), dim3(NT), args, LDS_BYTES, stream);
    if (e != hipSuccess) fprintf(stderr, "kernel_launch: cooperative launch failed: %s (grid %d)\n", hipGetErrorString(e), grid);
}
```

```cpp
#include <hip/hip_runtime.h>
#include <hip/hip_cooperative_groups.h>
#include <cstdio>
#include <cstdint>
#include <cmath>
namespace cg = cooperative_groups;
#define REP_P0 1
#define REP_P1 1
#define REP_ATT 1
#define REP_SATT 1
#define REP_CONV 1
#define REP_COMB 1
#define REP_P3 1
#define REP_P4 1
#define REP_P5 1
#define REP_SYNC 0
namespace pg8 {
#define PG8_LAS __attribute__((address_space(3)))
typedef unsigned short bf16_t;
typedef short bf16x8 __attribute__((ext_vector_type(8)));
typedef float f32x4 __attribute__((ext_vector_type(4)));
typedef unsigned u32x4 __attribute__((ext_vector_type(4)));
constexpr int BM = 256, BK = 64, HALF = 128, HTB = HALF * BK * 2  , STAGE_BYTES = 8 * HTB, NXCD = 8, WGM = 8;

__host__ __device__ __forceinline__ int lds_byte(int r, int c) { const int st = (r >> 4) * 2 + (c >> 5), rr = r & 15, cc = c & 31, ob = rr * 64 + cc * 2; return st * 1024 + (ob ^ (((ob >> 9) & 1) << 5)); }
__host__ __device__ __forceinline__ void stage_rc(int b, int& R, int& C) { const int st = b / 1024, sb = b % 1024, swz = sb ^ (((sb >> 9) & 1) << 5); R = (st >> 1) * 16 + swz / 64; C = (st & 1) * 32 + (swz % 64) / 2; }
__host__ __device__ __forceinline__ int perm32(int rho) { const int n = rho >> 4, i = rho & 15; return 8 * (i >> 2) + 4 * n + (i & 3); }

struct Unit { int pm, pn; };
struct Gemm { const bf16_t* A; const bf16_t* Bt; int M, N, K; };

struct StaticOrder {
    int nM, nN, nwg, G, c;
    __host__ __device__ void init(int M, int N, int G_, int c_) { nM = M / BM; nN = N / BM; nwg = nM * nN; G = G_; c = c_; }
    __host__ __device__ bool next(int i, Unit& u) const {
        const long L = (long)i * G + c; if (L >= nwg) return false;
        int wgid = (int)L; { const int q = nwg / NXCD, r = nwg % NXCD, xcd = wgid % NXCD, off = wgid / NXCD; wgid = (xcd < r ? xcd * (q + 1) : r * (q + 1) + (xcd - r) * q) + off; }
        const int nig = WGM * nN, gid = wgid / nig, fm = gid * WGM, gsz = (nM - fm) < WGM ? (nM - fm) : WGM;
        u.pm = fm + ((wgid % nig) % gsz); u.pn = (wgid % nig) / gsz; return true;
    }
    __device__ __forceinline__ void a_ready(const Unit&) const {}
    __device__ __forceinline__ void done(const Unit&) const {}
};

typedef unsigned u32x4 __attribute__((ext_vector_type(4)));
__device__ __forceinline__ unsigned cvt_pk_bf16(float lo, float hi) { unsigned r; asm volatile("v_cvt_pk_bf16_f32 %0, %1, %2" : "=v"(r) : "v"(lo), "v"(hi)); return r; }
__device__ __forceinline__ float bf_lo(unsigned u) { return __uint_as_float(u << 16); }
__device__ __forceinline__ float bf_hi(unsigned u) { return __uint_as_float(u & 0xffff0000u); }
__device__ __forceinline__ float sigm(float x) { return __builtin_amdgcn_rcpf(1.0f + __builtin_amdgcn_exp2f(-1.4426950408889634f * x)); }
constexpr int HP = 2560;
constexpr int HSP = 4608;

template <int WB> struct KvsCopy {
    static constexpr size_t per = (size_t)(WB - 8) * 256, tot = 32 * per;
    static __device__ __forceinline__ void load(const float* src, size_t base, f32x4 (&v)[9]) {
        const size_t b0 = base / per, w0 = base % per;
#pragma unroll
        for (int k = 0; k < 9; ++k) { size_t b = b0, w = w0 + (size_t)k * 512; if (w >= per) { w -= per; ++b; }
            if (b < 32) v[k] = __builtin_nontemporal_load((const f32x4*)src + b * (size_t)WB * 256 + 8 * 256 + w); }
    }
    static __device__ __forceinline__ void store(float* dst, size_t base, const f32x4 (&v)[9]) {
        const size_t b0 = base / per, w0 = base % per;
#pragma unroll
        for (int k = 0; k < 9; ++k) { size_t b = b0, w = w0 + (size_t)k * 512; if (w >= per) { w -= per; ++b; }
            if (b < 32) __builtin_nontemporal_store(v[k], (f32x4*)dst + b * (size_t)WB * 256 + w); }
    }
};
constexpr int KVS_U2 = 3627, KVS_U1 = 896, KVS_U0 = 214;
constexpr int KVS_E = 2600;

struct EpiIn {
    static constexpr bool PERM = true, AFTER_DRAIN = false, HAS_MID = false; static constexpr int MID_T = 0;
    bf16_t* Hb; bf16_t* Hs; bf16_t* U; bf16_t* ZA; bf16_t* QKVh; const float* bias; float qs; const float *c0, *c1, *c2; float *o0, *o1, *o2;
    __device__ __forceinline__ void mid(f32x4 (&acc)[2][2][4][2], const Unit& u, int wr, int wc, int fr, int fq) const {}
    __device__ __forceinline__ void operator()(const f32x4 (&acc)[2][2][4][2], const Unit& u, int wr, int wc, int fr, int fq) const {
        const int flat = u.pm * 40 + u.pn;
        int ct_; asm volatile("v_mov_b32 %0, %1" : "=v"(ct_) : "v"((int)threadIdx.x));
        const size_t ctid = (size_t)(unsigned)ct_;
        f32x4 cv[9];
        if (flat < KVS_E) KvsCopy<2048>::load(c2, (size_t)flat * 4608 + ctid, cv);
        const int row0 = u.pm * BM + wr * 64 + fr;
        const int bcol0 = u.pn * BM + wc * 32 + 8 * fq;
        f32x4 bv[2][2];
#pragma unroll
        for (int bj = 0; bj < 2; ++bj)
#pragma unroll
            for (int n = 0; n < 2; ++n) bv[bj][n] = *(const f32x4*)(bias + bcol0 + bj * HALF + 4 * n);
        if (u.pn < 8) {
            const int col0 = u.pn * 128 + wc * 32 + 8 * fq;
#pragma unroll
            for (int ai = 0; ai < 2; ++ai)
#pragma unroll
                for (int m = 0; m < 4; ++m) { bf16_t* rowp = U + (size_t)(row0 + ai * HALF + m * 16) * 1024 + col0;
                    f32x4 v0 = acc[ai][0][m][0] + bv[0][0], v1 = acc[ai][0][m][1] + bv[0][1], g0 = acc[ai][1][m][0] + bv[1][0], g1 = acc[ai][1][m][1] + bv[1][1];
#pragma unroll
                    for (int i = 0; i < 4; ++i) { v0[i] *= sigm(g0[i]); v1[i] *= sigm(g1[i]); }
                    u32x4 w; w.x = cvt_pk_bf16(v0[0], v0[1]); w.y = cvt_pk_bf16(v0[2], v0[3]); w.z = cvt_pk_bf16(v1[0], v1[1]); w.w = cvt_pk_bf16(v1[2], v1[3]);
                    *(u32x4*)rowp = w; }
        } else if (u.pn >= 12 && u.pn < 30 && u.pm < 128) {
            const int cidx = u.pn - 12, which = cidx / 6, gi = (cidx % 6) >> 1, h0 = ((cidx % 6) & 1) * 4, lg = 2 * gi;
            const float sc = (which == 0) ? qs : 1.0f;
            const int b = u.pm >> 4;
            const int d0 = (wc & 1) * 32 + 8 * fq;
#pragma unroll
            for (int ai = 0; ai < 2; ++ai)
#pragma unroll
                for (int m = 0; m < 4; ++m) { const int t = (row0 + ai * HALF + m * 16) & 4095; const int ti = ((t & ((1 << lg) - 1)) << (12 - lg)) + (t >> lg);
#pragma unroll
                    for (int bj = 0; bj < 2; ++bj) { const int h = h0 + bj * 2 + (wc >> 1);
                        const f32x4 v0 = (acc[ai][bj][m][0] + bv[bj][0]) * sc, v1 = (acc[ai][bj][m][1] + bv[bj][1]) * sc;
                        u32x4 w; w.x = cvt_pk_bf16(v0[0], v0[1]); w.y = cvt_pk_bf16(v0[2], v0[3]); w.z = cvt_pk_bf16(v1[0], v1[1]); w.w = cvt_pk_bf16(v1[2], v1[3]);
                        *(u32x4*)(QKVh + ((size_t)((((which * 8 + b) * 3 + gi) * 8 + h) * 4096 + ti)) * 64 + d0) = w; } }
        } else {
            const int pn = u.pn; const int mode = (pn < 12) ? 1 : (pn < 30) ? 0 : (pn < 32) ? 1 : 2; const float sc = (pn >= 12 && pn < 18) ? qs : 1.0f;
            bf16_t* base = (pn < 12) ? ZA + (pn * BM - 2048) : (pn < 30) ? Hs + (pn - 12) * BM - (size_t)32768 * HSP : Hb + (pn - 30) * BM; const int pitch = (pn < 12) ? 1024 : (pn < 30) ? HSP : HP;
            const int col0 = wc * 32 + 8 * fq;
#pragma unroll
            for (int ai = 0; ai < 2; ++ai)
#pragma unroll
                for (int m = 0; m < 4; ++m) { bf16_t* rowp = base + (size_t)(row0 + ai * HALF + m * 16) * pitch + col0;
#pragma unroll
                    for (int bj = 0; bj < 2; ++bj) { f32x4 v0 = acc[ai][bj][m][0] + bv[bj][0], v1 = acc[ai][bj][m][1] + bv[bj][1];
                        if (mode == 0) { v0 = v0 * sc; v1 = v1 * sc; }
                        else {
#pragma unroll
                            for (int i = 0; i < 4; ++i) { const float s0 = sigm(v0[i]), s1 = sigm(v1[i]); v0[i] = (mode == 1) ? v0[i] * s0 : s0; v1[i] = (mode == 1) ? v1[i] * s1 : s1; } }
                        u32x4 w; w.x = cvt_pk_bf16(v0[0], v0[1]); w.y = cvt_pk_bf16(v0[2], v0[3]); w.z = cvt_pk_bf16(v1[0], v1[1]); w.w = cvt_pk_bf16(v1[2], v1[3]);
                        *(u32x4*)(rowp + bj * HALF) = w; } }
        }
        if (flat < KVS_E) KvsCopy<2048>::store(o2, (size_t)flat * 4608 + ctid, cv);
    }
};

template <bool ADD> struct EpiGate {
    static constexpr bool PERM = true, AFTER_DRAIN = false, HAS_MID = false; static constexpr int MID_T = 0;
    const bf16_t* Hb; bf16_t* Mb; int gcol;
    __device__ __forceinline__ void mid(f32x4 (&acc)[2][2][4][2], const Unit& u, int wr, int wc, int fr, int fq) const {}
    __device__ __forceinline__ void operator()(const f32x4 (&acc)[2][2][4][2], const Unit& u, int wr, int wc, int fr, int fq) const {
        const int row0 = u.pm * BM + wr * 64 + fr, col0 = u.pn * BM + wc * 32 + 8 * fq;
#pragma unroll
        for (int ai = 0; ai < 2; ++ai)
#pragma unroll
            for (int m = 0; m < 4; ++m) { const size_t row = (size_t)(row0 + ai * HALF + m * 16); if (m == 0) asm volatile("" ::: "memory");
#pragma unroll
                for (int bj = 0; bj < 2; ++bj) { const u32x4 a = *(const u32x4*)(Hb + row * HP + gcol + col0 + bj * HALF);
                    u32x4 t = (u32x4){0u, 0u, 0u, 0u}; if (ADD) t = *(const u32x4*)(Mb + row * 1024 + col0 + bj * HALF);
                    const f32x4 v0 = acc[ai][bj][m][0], v1 = acc[ai][bj][m][1];
                    u32x4 w; w.x = cvt_pk_bf16(v0[0] * bf_lo(a.x) + bf_lo(t.x), v0[1] * bf_hi(a.x) + bf_hi(t.x)); w.y = cvt_pk_bf16(v0[2] * bf_lo(a.y) + bf_lo(t.y), v0[3] * bf_hi(a.y) + bf_hi(t.y));
                    w.z = cvt_pk_bf16(v1[0] * bf_lo(a.z) + bf_lo(t.z), v1[1] * bf_hi(a.z) + bf_hi(t.z)); w.w = cvt_pk_bf16(v1[2] * bf_lo(a.w) + bf_lo(t.w), v1[3] * bf_hi(a.w) + bf_hi(t.w));
                    *(u32x4*)(Mb + row * 1024 + col0 + bj * HALF) = w; } }
    }
};

struct EpiOut {
    static constexpr bool PERM = true, AFTER_DRAIN = false, HAS_MID = false; static constexpr int MID_T = 0;
    const float* xp; const float* xs; bf16_t* y; float alpha; int rp;
    __device__ __forceinline__ void mid(f32x4 (&acc)[2][2][4][2], const Unit& u, int wr, int wc, int fr, int fq) const {}
    __device__ __forceinline__ void operator()(const f32x4 (&acc)[2][2][4][2], const Unit& u, int wr, int wc, int fr, int fq) const {
        const int row0 = u.pm * BM + wr * 64 + fr, col0 = u.pn * BM + wc * 32 + 8 * fq;
#pragma unroll
        for (int ai = 0; ai < 2; ++ai)
#pragma unroll
            for (int m = 0; m < 4; ++m) { const int row = row0 + ai * HALF + m * 16; if (m == 0) asm volatile("" ::: "memory");
                const float* xr = (row < rp) ? xp + (size_t)row * 1024 : xs + (size_t)(row - rp) * 1024; bf16_t* yr = y + (size_t)row * 1024;
#pragma unroll
                for (int bj = 0; bj < 2; ++bj) { const f32x4 x0 = *(const f32x4*)(xr + col0 + bj * HALF), x1 = *(const f32x4*)(xr + col0 + bj * HALF + 4);
                    const f32x4 v0 = x0 * alpha + acc[ai][bj][m][0], v1 = x1 * alpha + acc[ai][bj][m][1];
                    u32x4 w; w.x = cvt_pk_bf16(v0[0], v0[1]); w.y = cvt_pk_bf16(v0[2], v0[3]); w.z = cvt_pk_bf16(v1[0], v1[1]); w.w = cvt_pk_bf16(v1[2], v1[3]);
                    *(u32x4*)(yr + col0 + bj * HALF) = w; } }
    }
};

template <class Epi, class Sched, bool ALIGN_EPI = false, bool SP2 = false>
__device__ __forceinline__ void gemm_phase(PG8_LAS unsigned char* lds, const Gemm g, const Sched& S, const Epi& E) {
    int tid_opaque; asm volatile("v_mov_b32 %0, %1" : "=v"(tid_opaque) : "v"((int)threadIdx.x));
    const int tid = tid_opaque, wid = __builtin_amdgcn_readfirstlane(tid >> 6), lane = tid & 63, wr = wid >> 2, wc = wid & 3, fr = lane & 15, fq = lane >> 4;
    const int K = g.K, nt = K / BK;
    unsigned voffA[2], voffB[2];
#pragma unroll
    for (int i = 0; i < 2; ++i) { int R, C; stage_rc(tid * 16 + i * 8192, R, C); const int Rb = Epi::PERM ? ((R & ~31) + perm32(R & 31)) : R;
        voffA[i] = (unsigned)(R * K + C) * 2u; voffB[i] = (unsigned)(Rb * K + C) * 2u; }
    const size_t kstep = (size_t)(BK * 2);
    const size_t hstep = (size_t)HALF * K * 2;
    const size_t tstep = 2 * hstep;
    const unsigned ldsw = (unsigned)wid * 1024u;
    const int aoff = lds_byte(wr * 64 + fr, fq * 8), boff = lds_byte(wc * 32 + fr, fq * 8);
#define PG8_SA(b, h) (((b) * 2 + (h)) * HTB)
#define PG8_SB(b, h) ((4 + (b) * 2 + (h)) * HTB)
#define PG8_STAGE(bufoff, gbase, voff) do { _Pragma("unroll") for (int _i = 0; _i < 2; ++_i) \
        __builtin_amdgcn_global_load_lds((const unsigned*)((const char*)(gbase) + (voff)[_i]), (PG8_LAS unsigned*)(lds + (bufoff) + ldsw + _i * 8192), 16, 0, 0); } while (0)
#define PG8_LDA(dst, b, h) do { _Pragma("unroll") for (int m = 0; m < 4; ++m) _Pragma("unroll") for (int k = 0; k < 2; ++k) dst[m][k] = *(const PG8_LAS bf16x8*)(lds + PG8_SA(b, h) + aoff + m * 2048 + k * 1024); } while (0)
#define PG8_LDB(dst, b, h) do { _Pragma("unroll") for (int n = 0; n < 2; ++n) _Pragma("unroll") for (int k = 0; k < 2; ++k) dst[n][k] = *(const PG8_LAS bf16x8*)(lds + PG8_SB(b, h) + boff + n * 2048 + k * 1024); } while (0)
#define PG8_MMA(ai, bj, At, Bt) do { __builtin_amdgcn_s_setprio(1); _Pragma("unroll") for (int m = 0; m < 4; ++m) _Pragma("unroll") for (int n = 0; n < 2; ++n) _Pragma("unroll") for (int k = 0; k < 2; ++k) \
        acc[ai][bj][m][n] = __builtin_amdgcn_mfma_f32_16x16x32_bf16(Bt[n][k], At[m][k], acc[ai][bj][m][n], 0, 0, 0); __builtin_amdgcn_s_setprio(0); } while (0)
#define PG8_WAIT_V(n) asm volatile("s_waitcnt vmcnt(" #n ")" ::: "memory")
#define PG8_WAIT_L(n) asm volatile("s_waitcnt lgkmcnt(" #n ")" ::: "memory")
#define PG8_BAR __builtin_amdgcn_s_barrier()
#define PG8_SCHED __builtin_amdgcn_sched_barrier(0)
    Unit cur, nxt; int ui = 0;
    if (!S.next(0, cur)) return;
    f32x4 acc[2][2][4][2];
#pragma unroll
    for (int a = 0; a < 2; ++a)
#pragma unroll
        for (int b = 0; b < 2; ++b)
#pragma unroll
            for (int m = 0; m < 4; ++m)
#pragma unroll
                for (int n = 0; n < 2; ++n) acc[a][b][m][n] = (f32x4){0.f, 0.f, 0.f, 0.f};
    bf16x8 At[4][2], B0[2][2], B1[2][2];
    const char* cA = (const char*)g.A + (size_t)cur.pm * tstep; const char* cB = (const char*)g.Bt + (size_t)cur.pn * tstep;
    S.a_ready(cur);
    if constexpr (SP2) {
        PG8_STAGE(PG8_SB(0, 0), cB, voffB); PG8_STAGE(PG8_SB(0, 1), cB + hstep, voffB); PG8_STAGE(PG8_SA(0, 0), cA, voffA); PG8_STAGE(PG8_SA(0, 1), cA + hstep, voffA);
        if (wr == 1) PG8_BAR;
        PG8_WAIT_V(2); PG8_BAR;
        PG8_STAGE(PG8_SB(1, 0), cB + kstep, voffB); PG8_STAGE(PG8_SA(1, 0), cA + kstep, voffA); PG8_STAGE(PG8_SB(1, 1), cB + hstep + kstep, voffB);
        PG8_WAIT_V(6); PG8_BAR;
    } else {
        PG8_STAGE(PG8_SB(0, 0), cB, voffB); PG8_STAGE(PG8_SA(0, 0), cA, voffA); PG8_STAGE(PG8_SB(0, 1), cB + hstep, voffB); PG8_STAGE(PG8_SA(0, 1), cA + hstep, voffA);
        if (wr == 1) PG8_BAR;
        PG8_WAIT_V(4); PG8_BAR;
        PG8_STAGE(PG8_SB(1, 0), cB + kstep, voffB); PG8_STAGE(PG8_SA(1, 0), cA + kstep, voffA); PG8_STAGE(PG8_SB(1, 1), cB + hstep + kstep, voffB);
        PG8_WAIT_V(6); PG8_BAR;
    }
    for (;;) {
        const bool has_next = S.next(ui + 1, nxt);
        const char* nA = has_next ? (const char*)g.A + (size_t)nxt.pm * tstep : cA; const char* nB = has_next ? (const char*)g.Bt + (size_t)nxt.pn * tstep : cB;
        for (int t = 0; t < nt; t += 2) {
            if constexpr (Epi::HAS_MID) { if (t == Epi::MID_T) E.mid(acc, cur, wr, wc, fr, fq); }
            const bool last = (t == nt - 2);
            const char* a1 = cA + (size_t)(t + 1) * kstep;
            const char* a2 = last ? nA : cA + (size_t)(t + 2) * kstep; const char* b2 = last ? nB : cB + (size_t)(t + 2) * kstep;
            const char* a3 = a2 + kstep; const char* b3 = b2 + kstep;
            if (last && has_next) S.a_ready(nxt);
            if constexpr (SP2) {
            PG8_LDB(B0, 0, 0); PG8_LDB(B1, 0, 1); PG8_SCHED; PG8_LDA(At, 0, 0); PG8_STAGE(PG8_SA(1, 1), a1 + hstep, voffA);
            PG8_WAIT_V(8); PG8_WAIT_L(0); PG8_BAR; PG8_MMA(0, 0, At, B0); PG8_MMA(0, 1, At, B1); PG8_BAR; PG8_SCHED;
            PG8_LDA(At, 0, 1); PG8_STAGE(PG8_SB(0, 0), b2, voffB); PG8_STAGE(PG8_SB(0, 1), b2 + hstep, voffB); PG8_STAGE(PG8_SA(0, 0), a2, voffA);
            PG8_WAIT_V(8); PG8_WAIT_L(0); PG8_BAR; PG8_MMA(1, 0, At, B0); PG8_MMA(1, 1, At, B1); PG8_BAR; PG8_SCHED;
            PG8_LDB(B0, 1, 0); PG8_LDB(B1, 1, 1); PG8_SCHED; PG8_LDA(At, 1, 0); PG8_STAGE(PG8_SA(0, 1), a2 + hstep, voffA);
            PG8_WAIT_V(8); PG8_WAIT_L(0); PG8_BAR; PG8_MMA(0, 0, At, B0); PG8_MMA(0, 1, At, B1); PG8_BAR; PG8_SCHED;
            PG8_LDA(At, 1, 1); PG8_STAGE(PG8_SB(1, 0), b3, voffB); PG8_STAGE(PG8_SB(1, 1), b3 + hstep, voffB); PG8_STAGE(PG8_SA(1, 0), a3, voffA);
            PG8_WAIT_V(8); PG8_WAIT_L(0); PG8_BAR; PG8_MMA(1, 0, At, B0); PG8_MMA(1, 1, At, B1); PG8_BAR; PG8_SCHED;
            } else {
            PG8_LDB(B0, 0, 0); PG8_SCHED; PG8_LDA(At, 0, 0); PG8_STAGE(PG8_SA(1, 1), a1 + hstep, voffA);
            PG8_WAIT_L(8); PG8_BAR; PG8_WAIT_L(0); PG8_MMA(0, 0, At, B0); PG8_BAR; PG8_SCHED;
            PG8_LDB(B1, 0, 1); PG8_STAGE(PG8_SB(0, 0), b2, voffB);
            PG8_BAR; PG8_WAIT_L(0); PG8_MMA(0, 1, At, B1); PG8_BAR;
            PG8_LDA(At, 0, 1); PG8_STAGE(PG8_SA(0, 0), a2, voffA);
            PG8_BAR; PG8_WAIT_L(0); PG8_MMA(1, 0, At, B0); PG8_BAR; PG8_SCHED;
            PG8_STAGE(PG8_SB(0, 1), b2 + hstep, voffB);
            PG8_WAIT_V(6); PG8_BAR; PG8_MMA(1, 1, At, B1); PG8_BAR;
            PG8_LDB(B0, 1, 0); PG8_SCHED; PG8_LDA(At, 1, 0); PG8_STAGE(PG8_SA(0, 1), a2 + hstep, voffA);
            PG8_WAIT_L(8); PG8_BAR; PG8_WAIT_L(0); PG8_MMA(0, 0, At, B0); PG8_BAR; PG8_SCHED;
            PG8_LDB(B1, 1, 1); PG8_STAGE(PG8_SB(1, 0), b3, voffB);
            PG8_BAR; PG8_WAIT_L(0); PG8_MMA(0, 1, At, B1); PG8_BAR;
            PG8_LDA(At, 1, 1); PG8_STAGE(PG8_SA(1, 0), a3, voffA);
            PG8_BAR; PG8_WAIT_L(0); PG8_MMA(1, 0, At, B0); PG8_BAR; PG8_SCHED;
            PG8_STAGE(PG8_SB(1, 1), b3 + hstep, voffB);
            PG8_WAIT_V(6); PG8_BAR; PG8_MMA(1, 1, At, B1); PG8_BAR;
            }
        }
        if constexpr (ALIGN_EPI) { if (wr == 0) PG8_BAR; }
        if constexpr (!Epi::AFTER_DRAIN) { E(acc, cur, wr, wc, fr, fq); S.done(cur); }
        if (!has_next) break;
#pragma unroll
        for (int a = 0; a < 2; ++a)
#pragma unroll
            for (int b = 0; b < 2; ++b)
#pragma unroll
                for (int m = 0; m < 4; ++m)
#pragma unroll
                    for (int n = 0; n < 2; ++n) acc[a][b][m][n] = (f32x4){0.f, 0.f, 0.f, 0.f};
        cur = nxt; cA = nA; cB = nB; ++ui;
        if constexpr (ALIGN_EPI) { if (wr == 1) PG8_BAR; }
    }
    PG8_WAIT_V(0);
    if constexpr (!ALIGN_EPI) { if (wr == 0) PG8_BAR; }
    PG8_BAR;
    if constexpr (Epi::AFTER_DRAIN) { E.fused(acc, cur, wr, wc, fr, fq, lds, wid, lane); S.done(cur); }
#undef PG8_SA
#undef PG8_SB
#undef PG8_STAGE
#undef PG8_LDA
#undef PG8_LDB
#undef PG8_MMA
#undef PG8_WAIT_V
#undef PG8_WAIT_L
#undef PG8_BAR
#undef PG8_SCHED
}
}
#define LAS __attribute__((address_space(3)))
typedef unsigned short bf16;
typedef unsigned u32x4 __attribute__((ext_vector_type(4)));
typedef unsigned u32x2 __attribute__((ext_vector_type(2)));
typedef float f32x4 __attribute__((ext_vector_type(4)));
typedef float f32x2 __attribute__((ext_vector_type(2)));
typedef float f32x16 __attribute__((ext_vector_type(16)));
typedef short bf16x8 __attribute__((ext_vector_type(8)));
using pg8::cvt_pk_bf16; using pg8::bf_lo; using pg8::bf_hi; using pg8::sigm; using pg8::HP; using pg8::HSP;

constexpr int NWAVES = 8, NT = 512;
constexpr int D = 1024, SEQ = 4096, NB = 8, RP = NB * SEQ, RS = 256, R = RP + RS, INW = 10240;
constexpr int HC_ZB = 0, HC_GA = 512, HC_GB = 1536;
constexpr int HS_Q = 0, HS_K = 1536, HS_V = 3072;
constexpr float LOG2E = 1.4426950408889634f, LN2 = 0.6931471805599453f;
constexpr float QS = 0.125f * LOG2E;
constexpr float ALPHA = 1.189207115002721f;
constexpr float LN_EPS = 1e-5f;
constexpr size_t MiB = 1u << 20;
constexpr size_t WS_WIN = 0 * MiB, WS_WA = 21 * MiB, WS_WB = 24 * MiB, WS_WO = 26 * MiB, WS_BP = 29 * MiB, WS_XB = 31 * MiB, WS_CA = 97 * MiB, WS_AB = 163 * MiB, WS_MB = 197 * MiB, WS_OG = 263 * MiB, WS_LSE = 361 * MiB, WS_SP = 366 * MiB, WS_HB = 382 * MiB, WS_HS = 545 * MiB, WS_U = 549 * MiB, WS_ZA = 615 * MiB, WS_QKV = 681 * MiB, WS_Y = 970 * MiB, WS_BAR = 1036 * MiB, WS_END = 1038 * MiB;
constexpr size_t O_YP = 0, O_YS = 33554432, O_KVP0 = 33816576, O_KVP1 = 34865152, O_KVP2 = 39059456, O_CONVP = 55836672, O_KVS0 = 56082432, O_KVS1 = 60276736, O_KVS2 = 77053952, O_CONVS = 144162816;
constexpr int RING_BYTES = 131072, LDS_BYTES = 147456, LDS_MISC = LDS_BYTES - 64;

struct Args {
    const float *xp, *xs, *c0, *c1, *c2, *sconv, *w_in, *b_in, *conv_w, *conv_b, *cln_g, *cln_b, *w_a, *w_b, *w_out, *ln_g, *ln_b;
    float* out; unsigned char* ws;
};

#define LDS_WAIT() asm volatile("s_waitcnt lgkmcnt(0)" ::: "memory")

__device__ __forceinline__ void tr_item(const float* W, int ldw, int k0, int n0, bf16* dst, int ldT, LAS float* scr, int lane) {
#pragma unroll 8
    for (int i = 0; i < 32; ++i) { const int kk = 2 * i + (lane >> 5); scr[kk * 33 + (lane & 31)] = W[(size_t)(k0 + kk) * ldw + n0 + (lane & 31)]; }
    LDS_WAIT();
    const int c = lane & 7;
#pragma unroll
    for (int j = 0; j < 4; ++j) { const int n = (lane >> 3) + 8 * j; const LAS float* s = scr + (8 * c) * 33 + n;
        u32x4 o; o.x = cvt_pk_bf16(s[0 * 33], s[1 * 33]); o.y = cvt_pk_bf16(s[2 * 33], s[3 * 33]); o.z = cvt_pk_bf16(s[4 * 33], s[5 * 33]); o.w = cvt_pk_bf16(s[6 * 33], s[7 * 33]);
        *(u32x4*)(dst + (size_t)n * ldT + 8 * c) = o; }
    LDS_WAIT();
}
__device__ __forceinline__ int perm_in(int n) { if (n >= 2048) return n; const int half = n >> 10, c = n & 1023; return (c >> 7) * 256 + half * 128 + (c & 127); }

template <int WB> __device__ __forceinline__ void kvs_copy(const float* src, float* dst, int tid, int G) {
    constexpr size_t per = (size_t)(WB - 8) * 256, tot = 32 * per;
    for (size_t i0 = (size_t)blockIdx.x * NT * 8 + tid; i0 < tot; i0 += (size_t)G * NT * 8) {
        f32x4 v[8];
#pragma unroll
        for (int k = 0; k < 8; ++k) { const size_t i = i0 + (size_t)k * NT; if (i < tot) { const size_t b = i / per, w = i % per; v[k] = __builtin_nontemporal_load((const f32x4*)src + b * (size_t)WB * 256 + 8 * 256 + w); } }
#pragma unroll
        for (int k = 0; k < 8; ++k) { const size_t i = i0 + (size_t)k * NT; if (i < tot) { const size_t b = i / per, w = i % per; __builtin_nontemporal_store(v[k], (f32x4*)dst + b * (size_t)WB * 256 + w); } }
    }
}
template <int WB> __device__ __forceinline__ void kvs_copy_range(const float* src, float* dst, size_t i_begin, int tid, int bi, int nb) {
    constexpr size_t per = (size_t)(WB - 8) * 256, tot = 32 * per;
    for (size_t i0 = i_begin + (size_t)bi * NT * 8 + tid; i0 < tot; i0 += (size_t)nb * NT * 8) {
        f32x4 v[8];
#pragma unroll
        for (int k = 0; k < 8; ++k) { const size_t i = i0 + (size_t)k * NT; if (i < tot) { const size_t b = i / per, w = i % per; v[k] = __builtin_nontemporal_load((const f32x4*)src + b * (size_t)WB * 256 + 8 * 256 + w); } }
#pragma unroll
        for (int k = 0; k < 8; ++k) { const size_t i = i0 + (size_t)k * NT; if (i < tot) { const size_t b = i / per, w = i % per; __builtin_nontemporal_store(v[k], (f32x4*)dst + b * (size_t)WB * 256 + w); } }
    }
}
__device__ __forceinline__ void phase0(const Args& a, LAS unsigned char* lds, int tid, int lane, int wave, int G) {
    unsigned char* ws = a.ws;
    bf16* WinT = (bf16*)(ws + WS_WIN); bf16* WaT = (bf16*)(ws + WS_WA); bf16* WbT = (bf16*)(ws + WS_WB); bf16* WoT = (bf16*)(ws + WS_WO); float* bp = (float*)(ws + WS_BP); bf16* Xb = (bf16*)(ws + WS_XB);
    LAS float* scr = (LAS float*)(lds + wave * 16384);
    const int gw = blockIdx.x * NWAVES + wave, NGW = G * NWAVES;
    constexpr int I_IN = 16 * 320, I_B = 8 * 32, I_A = 16 * 32, I_O = 16 * 32, NITEMS = I_IN + I_B + I_A + I_O;
    for (int it = gw; it < NITEMS; it += NGW) {
        int r = it;
        if (r < I_IN) { const int kb = r / 320, nb = r % 320; tr_item(a.w_in, INW, 64 * kb, 32 * nb, WinT + (size_t)perm_in(32 * nb) * 1024 + 64 * kb, 1024, scr, lane); continue; } r -= I_IN;
        if (r < I_B) { const int kb = r / 32, nb = r % 32; tr_item(a.w_b, 1024, 64 * kb, 32 * nb, WbT + (size_t)(32 * nb) * 512 + 64 * kb, 512, scr, lane); continue; } r -= I_B;
        if (r < I_A) { const int kb = r / 32, nb = r % 32; tr_item(a.w_a, 1024, 64 * kb, 32 * nb, WaT + (size_t)(32 * nb) * 1024 + 64 * kb, 1024, scr, lane); continue; } r -= I_A;
        { const int kb = r / 32, nb = r % 32; tr_item(a.w_out, 1024, 64 * kb, 32 * nb, WoT + (size_t)(32 * nb) * 1024 + 64 * kb, 1024, scr, lane); }
    }
    for (int n = blockIdx.x * NT + tid; n < INW; n += G * NT) bp[perm_in(n)] = a.b_in[n];
    for (int q = gw; q < R / 4; q += NGW) {
        f32x4 v[4][4];
#pragma unroll
        for (int k = 0; k < 4; ++k) { const int m = 4 * q + k; const f32x4* xr = (const f32x4*)((m < RP) ? a.xp + (size_t)m * D : a.xs + (size_t)(m - RP) * D) + lane;
#pragma unroll
            for (int j = 0; j < 4; ++j) v[k][j] = __builtin_nontemporal_load(xr + 64 * j); }
#pragma unroll
        for (int k = 0; k < 4; ++k) { u32x2* o8 = (u32x2*)(Xb + (size_t)(4 * q + k) * D) + lane;
#pragma unroll
            for (int j = 0; j < 4; ++j) { u32x2 o; o.x = cvt_pk_bf16(v[k][j].x, v[k][j].y); o.y = cvt_pk_bf16(v[k][j].z, v[k][j].w); o8[64 * j] = o; } }
    }
}

constexpr int KS_PITCH = 144, VT_PITCH = 776, LDS_KS = 0, LDS_VT = 384 * KS_PITCH  , LDS_WSF = LDS_VT + 64 * VT_PITCH  ;
struct AttnPre { u32x4 k[6]; u32x4 v0[3]; u32x4 v1[3]; bf16x8 q[4]; };
__device__ __forceinline__ void attn_decode(int uidx, int& b, int& h, int& g, int& d, int& res, int& blk) {
    const int bh = uidx / 48, s = uidx % 48; b = bh >> 3; h = bh & 7;
    if (s < 16) { g = 0; d = 1; res = 0; blk = s; } else if (s < 32) { g = 1; d = 4; res = (s - 16) >> 2; blk = (s - 16) & 3; } else { g = 2; d = 16; res = s - 32; blk = 0; }
}
__device__ __forceinline__ void attn_load(const bf16* QKVh, int uidx, int tid, int lane, int wave, AttnPre& p) {
    int b, h, g, d, res, blk; attn_decode(uidx, b, h, g, d, res, blk);
    const int L = SEQ / d;
    const bf16* Qr = QKVh + ((size_t)((((0 * 8 + b) * 3 + g) * 8 + h) * 4096 + res * L)) * 64;
    const bf16* Kr = QKVh + ((size_t)((((1 * 8 + b) * 3 + g) * 8 + h) * 4096 + res * L)) * 64;
    const bf16* Vr = QKVh + ((size_t)((((2 * 8 + b) * 3 + g) * 8 + h) * 4096 + res * L)) * 64;
    const int i0 = 256 * blk - 128;
#pragma unroll
    for (int i = 0; i < 6; ++i) { const int c = tid + NT * i, kk = c >> 3, ch = c & 7, ik = i0 + kk;
        p.k[i] = (u32x4){0u, 0u, 0u, 0u};
        if (ik >= 0) p.k[i] = *(const u32x4*)(Kr + (size_t)ik * 64 + ch * 8); }
#pragma unroll
    for (int i = 0; i < 3; ++i) { const int c = tid + NT * i, kp = c % 192, ch = c / 192, ik = i0 + 2 * kp;
        p.v0[i] = (u32x4){0u, 0u, 0u, 0u}; p.v1[i] = p.v0[i];
        if (ik >= 0) { p.v0[i] = *(const u32x4*)(Vr + (size_t)ik * 64 + ch * 8); p.v1[i] = *(const u32x4*)(Vr + (size_t)(ik + 1) * 64 + ch * 8); } }
    const int qp = lane & 31, hi = lane >> 5, iq = 256 * blk + 32 * wave + qp;
    const bf16* qr = Qr + (size_t)iq * 64 + 8 * hi;
#pragma unroll
    for (int kd = 0; kd < 4; ++kd) p.q[kd] = *(const bf16x8*)(qr + 16 * kd);
}
__device__ __forceinline__ void attn_stage(LAS unsigned char* lds, const AttnPre& p, int tid) {
#pragma unroll
    for (int i = 0; i < 6; ++i) { const int c = tid + NT * i, kk = c >> 3, ch = c & 7; *(LAS u32x4*)(lds + LDS_KS + kk * KS_PITCH + ch * 16) = p.k[i]; }
#pragma unroll
    for (int i = 0; i < 3; ++i) { const int c = tid + NT * i, kp = c % 192, ch = c / 192; const u32x4 v0 = p.v0[i], v1 = p.v1[i];
        LAS unsigned char* vp = lds + LDS_VT + (8 * ch) * VT_PITCH + 4 * kp;
        *(LAS unsigned*)(vp + 0 * VT_PITCH) = (v0.x & 0xffffu) | (v1.x << 16);  *(LAS unsigned*)(vp + 1 * VT_PITCH) = (v0.x >> 16) | (v1.x & 0xffff0000u);
        *(LAS unsigned*)(vp + 2 * VT_PITCH) = (v0.y & 0xffffu) | (v1.y << 16);  *(LAS unsigned*)(vp + 3 * VT_PITCH) = (v0.y >> 16) | (v1.y & 0xffff0000u);
        *(LAS unsigned*)(vp + 4 * VT_PITCH) = (v0.z & 0xffffu) | (v1.z << 16);  *(LAS unsigned*)(vp + 5 * VT_PITCH) = (v0.z >> 16) | (v1.z & 0xffff0000u);
        *(LAS unsigned*)(vp + 6 * VT_PITCH) = (v0.w & 0xffffu) | (v1.w << 16);  *(LAS unsigned*)(vp + 7 * VT_PITCH) = (v0.w >> 16) | (v1.w & 0xffff0000u); }
}
__device__ __forceinline__ void attn_compute(LAS unsigned char* lds, const bf16x8 (&qf)[4], bf16* Og, float* Lse, int uidx, int tid, int lane, int wave) {
    int b, h, g, d, res, blk; attn_decode(uidx, b, h, g, d, res, blk);
    const int qp = lane & 31, hi = lane >> 5;
    const int iq = 256 * blk + 32 * wave + qp;
    const float cb = -__builtin_amdgcn_exp2f(-(float)(h + 1)) * (float)d * LOG2E;
    const float lb = cb * (float)(qp - 4 * hi);
    f32x16 S[5];
#pragma unroll
    for (int kt = 0; kt < 5; ++kt) {
        const bool tv = !(blk == 0 && wave + kt < 4);
#pragma unroll
        for (int r = 0; r < 16; ++r) S[kt][r] = lb;
        if (tv) {
            const LAS unsigned char* kb = lds + LDS_KS + (32 * wave + 32 * kt + qp) * KS_PITCH + 16 * hi;
#pragma unroll
            for (int kd = 0; kd < 4; ++kd) { const bf16x8 af = *(const LAS bf16x8*)(kb + 32 * kd); S[kt] = __builtin_amdgcn_mfma_f32_32x32x16_bf16(af, qf[kd], S[kt], 0, 0, 0); }
        }
#pragma unroll
        for (int r = 0; r < 16; ++r) { const int kl0 = (r & 3) + 8 * (r >> 2); float v = S[kt][r] + cb * (float)(128 - 32 * kt - kl0);
            const int kl = kl0 + 4 * hi;
            if (kt == 0) { if (kl < qp) v = -INFINITY; }
            if (kt == 4) { if (kl > qp) v = -INFINITY; }
            if (!tv) v = -INFINITY;
            S[kt][r] = v; }
    }
    float mx = -INFINITY;
#pragma unroll
    for (int kt = 0; kt < 5; ++kt)
#pragma unroll
        for (int r = 0; r < 16; ++r) mx = fmaxf(mx, S[kt][r]);
    mx = fmaxf(mx, __shfl_xor(mx, 32));
    float l = 0.f;
#pragma unroll
    for (int kt = 0; kt < 5; ++kt)
#pragma unroll
        for (int r = 0; r < 16; ++r) { const float p = __builtin_amdgcn_exp2f(S[kt][r] - mx); S[kt][r] = p; l += p; }
    l += __shfl_xor(l, 32);
    LAS float* wsf = (LAS float*)(lds + LDS_WSF) + wave * 32;
    if (hi == 0) wsf[qp] = __builtin_amdgcn_rcpf(l);
    f32x16 O[2];
#pragma unroll
    for (int r = 0; r < 16; ++r) { O[0][r] = 0.f; O[1][r] = 0.f; }
#pragma unroll
    for (int kt = 0; kt < 5; ++kt) {
        const bool tv = !(blk == 0 && wave + kt < 4);
        if (tv) {
#pragma unroll
            for (int kb2 = 0; kb2 < 2; ++kb2) {
                u32x4 pw; pw.x = cvt_pk_bf16(S[kt][8 * kb2 + 0], S[kt][8 * kb2 + 1]); pw.y = cvt_pk_bf16(S[kt][8 * kb2 + 2], S[kt][8 * kb2 + 3]);
                pw.z = cvt_pk_bf16(S[kt][8 * kb2 + 4], S[kt][8 * kb2 + 5]); pw.w = cvt_pk_bf16(S[kt][8 * kb2 + 6], S[kt][8 * kb2 + 7]);
                const bf16x8 pa = __builtin_bit_cast(bf16x8, pw);
#pragma unroll
                for (int nt = 0; nt < 2; ++nt) {
                    const LAS unsigned char* vp = lds + LDS_VT + (32 * nt + qp) * VT_PITCH + 2 * (32 * wave + 32 * kt + 16 * kb2 + 4 * hi);
                    const u32x2 lo = *(const LAS u32x2*)vp, hi2 = *(const LAS u32x2*)(vp + 16);
                    u32x4 vw; vw.x = lo.x; vw.y = lo.y; vw.z = hi2.x; vw.w = hi2.y;
                    O[nt] = __builtin_amdgcn_mfma_f32_32x32x16_bf16(pa, __builtin_bit_cast(bf16x8, vw), O[nt], 0, 0, 0);
                }
            }
        }
    }
    LDS_WAIT();
    bf16* og = Og + ((size_t)g * R + (size_t)b * SEQ) * 512 + h * 64 + qp;
#pragma unroll
    for (int r = 0; r < 16; ++r) { const int ql = (r & 3) + 8 * (r >> 2) + 4 * hi; const float li = wsf[ql];
        const size_t tok = (size_t)((256 * blk + 32 * wave + ql) * d + res);
        const unsigned w0 = cvt_pk_bf16(O[0][r] * li, O[1][r] * li);
        og[tok * 512] = (bf16)(w0 & 0xffffu); og[tok * 512 + 32] = (bf16)(w0 >> 16); }
    if (hi == 0) Lse[((size_t)g * R + (size_t)b * SEQ + (size_t)(iq * d + res)) * 8 + h] = (mx + __builtin_amdgcn_logf(l)) * LN2;
}

__device__ __forceinline__ float red8(float v) {
    v += __builtin_bit_cast(float, __builtin_amdgcn_update_dpp(0, __builtin_bit_cast(int, v), 0xB1, 0xF, 0xF, true));
    v += __builtin_bit_cast(float, __builtin_amdgcn_update_dpp(0, __builtin_bit_cast(int, v), 0x4E, 0xF, 0xF, true));
    v += __builtin_bit_cast(float, __builtin_amdgcn_update_dpp(0, __builtin_bit_cast(int, v), 0x141, 0xF, 0xF, true));
    return v;
}
__device__ __forceinline__ void sattn_task(const Args& a, const bf16* Hs, float* Sp, int task, int lane) {
    const int chunk = task & 7, bt = task >> 3, t = bt & 7, bg = bt >> 3, g = bg % 3, b = bg / 3;
    const int d = (g == 0) ? 1 : (g == 1) ? 4 : 16, wb = 128 * d;
    const float* cache = (g == 0) ? a.c0 : (g == 1) ? a.c1 : a.c2;
    const int j0 = (chunk == 0) ? 0 : 17 + 16 * (chunk - 1), j1 = 17 + 16 * chunk;
    const int h = lane >> 3;
    const float sl = __builtin_amdgcn_exp2f(-(float)(h + 1)) * LOG2E * (float)d;
    float q[8];
    { const u32x4 qv = *(const u32x4*)(Hs + (size_t)(b * 8 + t) * HSP + HS_Q + g * 512 + lane * 8);
      q[0] = bf_lo(qv.x); q[1] = bf_hi(qv.x); q[2] = bf_lo(qv.y); q[3] = bf_hi(qv.y); q[4] = bf_lo(qv.z); q[5] = bf_hi(qv.z); q[6] = bf_lo(qv.w); q[7] = bf_hi(qv.w); }
    float m = -INFINITY, l = 0.f, o[8];
#pragma unroll
    for (int i = 0; i < 8; ++i) o[i] = 0.f;
    int j = j0;
#define SATTN_STEP(kv, vv, jj) do { float s_ = 0.f; _Pragma("unroll") for (int i_ = 0; i_ < 8; ++i_) s_ += q[i_] * kv[i_]; \
        s_ = red8(s_); s_ -= sl * (float)(jj); \
        const float mn_ = fmaxf(m, s_), f_ = __builtin_amdgcn_exp2f(m - mn_), p_ = __builtin_amdgcn_exp2f(s_ - mn_); l = l * f_ + p_; \
        _Pragma("unroll") for (int i_ = 0; i_ < 8; ++i_) o[i_] = o[i_] * f_ + p_ * vv[i_]; m = mn_; } while (0)
    for (; j < j1 && t - j * d >= 0; ++j) {
        const bf16* rp = Hs + (size_t)(b * 8 + t - j * d) * HSP + g * 512 + lane * 8;
        const u32x4 kv4 = *(const u32x4*)(rp + HS_K), vv4 = *(const u32x4*)(rp + HS_V);
        float kf[8], vf[8];
        kf[0] = bf_lo(kv4.x); kf[1] = bf_hi(kv4.x); kf[2] = bf_lo(kv4.y); kf[3] = bf_hi(kv4.y); kf[4] = bf_lo(kv4.z); kf[5] = bf_hi(kv4.z); kf[6] = bf_lo(kv4.w); kf[7] = bf_hi(kv4.w);
        vf[0] = bf_lo(vv4.x); vf[1] = bf_hi(vv4.x); vf[2] = bf_lo(vv4.y); vf[3] = bf_hi(vv4.y); vf[4] = bf_lo(vv4.z); vf[5] = bf_hi(vv4.z); vf[6] = bf_lo(vv4.w); vf[7] = bf_hi(vv4.w);
        SATTN_STEP(kf, vf, j);
    }
    const float* cb = cache + (size_t)b * wb * 1024 + lane * 8;
#pragma unroll 4
    for (; j < j1; ++j) {
        const float* rp = cb + (size_t)(wb + t - j * d) * 1024;
        const f32x4 k0 = *(const f32x4*)rp, k1 = *(const f32x4*)(rp + 4), v0 = *(const f32x4*)(rp + 512), v1 = *(const f32x4*)(rp + 516);
        float kf[8] = {k0.x, k0.y, k0.z, k0.w, k1.x, k1.y, k1.z, k1.w}, vf[8] = {v0.x, v0.y, v0.z, v0.w, v1.x, v1.y, v1.z, v1.w};
        SATTN_STEP(kf, vf, j);
    }
#undef SATTN_STEP
    float* sp = Sp + (size_t)task * 640 + lane;
    sp[0] = m; sp[64] = l;
#pragma unroll
    for (int i = 0; i < 8; ++i) sp[128 + 64 * i] = o[i];
}

template <int RR> struct ConvRows {
    static __device__ __forceinline__ void run(f32x2 (&acc)[16], const f32x2 (&w)[31], const LAS unsigned char* p) {
        const unsigned uu = *(const LAS unsigned*)(p + RR * 2048); const f32x2 u = (f32x2){bf_lo(uu), bf_hi(uu)};
        constexpr int JLO = RR > 15 ? RR - 15 : 0, JHI = RR < 30 ? RR : 30;
#pragma unroll
        for (int j = JLO; j <= JHI; ++j) acc[RR - j] += u * w[j];
        if ((RR & 7) == 7) asm volatile("" ::: "memory");
        ConvRows<RR + 1>::run(acc, w, p);
    }
};
template <> struct ConvRows<46> { static __device__ __forceinline__ void run(f32x2 (&)[16], const f32x2 (&)[31], const LAS unsigned char*) {} };
constexpr int LDS_RED = 62 * 2048  , LDS_STAT = LDS_RED + 2048;
__device__ __forceinline__ void conv_tile(const Args& a, LAS unsigned char* lds, const bf16* Ub, const bf16* ZAb, bf16* CA, int tile, int tid, int lane, int wave,
                                          float cb0, float cb1, float lg0, float lg1, float lbb0, float lbb1) {
    const bool samp = tile >= 1024; const int b = samp ? tile - 1024 : tile >> 7, tt = tile & 127, t0 = 32 * tt;
    const int ntok = samp ? 8 : 32;
    const size_t rowbase = samp ? (size_t)(RP + b * 8) : (size_t)b * SEQ + t0;
#pragma unroll 4
    for (int i = 0; i < 16; ++i) { const int c = tid + NT * i; if (c < 62 * 128) { const int rr = c >> 7, ch = c & 127;
        u32x4 v = (u32x4){0u, 0u, 0u, 0u};
        if (!samp) { const int t = t0 - 30 + rr; if (t >= 0) v = *(const u32x4*)(Ub + ((size_t)b * SEQ + t) * 1024 + ch * 8); }
        else if (rr < 30) { const f32x4* sp = (const f32x4*)(a.sconv + ((size_t)b * 30 + rr) * 1024 + ch * 8); const f32x4 x0 = sp[0], x1 = sp[1];
            v.x = cvt_pk_bf16(x0.x, x0.y); v.y = cvt_pk_bf16(x0.z, x0.w); v.z = cvt_pk_bf16(x1.x, x1.y); v.w = cvt_pk_bf16(x1.z, x1.w); }
        else if (rr < 38) v = *(const u32x4*)(Ub + (size_t)(RP + b * 8 + rr - 30) * 1024 + ch * 8);
        *(LAS u32x4*)(lds + rr * 2048 + ch * 16) = v; } }
    f32x2 w[31];
#pragma unroll
    for (int j = 0; j < 31; ++j) w[j] = *(const f32x2*)(a.conv_w + j * 1024 + 2 * tid);
    __syncthreads();
    if (!samp && tt == 127) {
        float* cp = a.out + O_CONVP + (size_t)b * 30 * 1024 + 2 * tid;
#pragma unroll 6
        for (int k = 0; k < 30; ++k) { const unsigned uu = *(const LAS unsigned*)(lds + (32 + k) * 2048 + tid * 4); *(f32x2*)(cp + (size_t)k * 1024) = (f32x2){bf_lo(uu), bf_hi(uu)}; }
    }
    if (samp) {
        float* cp = a.out + O_CONVS + (size_t)b * 30 * 1024 + 2 * tid;
        for (int k = 0; k < 22; ++k) *(f32x2*)(cp + (size_t)k * 1024) = *(const f32x2*)(a.sconv + ((size_t)b * 30 + k + 8) * 1024 + 2 * tid);
        for (int k = 22; k < 30; ++k) { const unsigned uu = *(const LAS unsigned*)(lds + (30 + k - 22) * 2048 + tid * 4); *(f32x2*)(cp + (size_t)k * 1024) = (f32x2){bf_lo(uu), bf_hi(uu)}; }
    }
    LAS float* red = (LAS float*)(lds + LDS_RED); LAS f32x2* stat = (LAS f32x2*)(lds + LDS_STAT);
    const int nhalf = samp ? 1 : 2;
    for (int half = 0; half < nhalf; ++half) {
        f32x2 acc[16];
#pragma unroll
        for (int i = 0; i < 16; ++i) acc[i] = (f32x2){cb0, cb1};
        const bf16* zap = ZAb + (rowbase + half * 16) * 1024 + 2 * tid;
        unsigned zav[16];
#pragma unroll
        for (int to = 0; to < 16; ++to) zav[to] = (to < ntok) ? *(const unsigned*)(zap + (size_t)to * 1024) : 0u;
        ConvRows<0>::run(acc, w, lds + half * 16 * 2048 + tid * 4);
        asm volatile("" ::: "memory");
        float tot;
        { float vals[32];
#pragma unroll
          for (int i = 0; i < 16; ++i) { vals[i] = acc[i].x + acc[i].y; vals[16 + i] = acc[i].x * acc[i].x + acc[i].y * acc[i].y; }
#define BFLY(off) do { const bool up_ = (lane & (off)) != 0; _Pragma("unroll") for (int i_ = 0; i_ < (off); ++i_) { const float lo_ = vals[i_], hi_ = vals[i_ + (off)]; \
        const float send_ = up_ ? lo_ : hi_, keep_ = up_ ? hi_ : lo_; vals[i_] = keep_ + __shfl_xor(send_, (off)); } } while (0)
          BFLY(16); BFLY(8); BFLY(4); BFLY(2); BFLY(1);
#undef BFLY
          tot = vals[0] + __shfl_xor(vals[0], 32); }
        if (lane < 32) red[wave * 32 + lane] = tot;
        __syncthreads();
        if (tid < 16) { float s1 = 0.f, s2 = 0.f;
#pragma unroll
            for (int wv = 0; wv < 8; ++wv) { s1 += red[wv * 32 + tid]; s2 += red[wv * 32 + 16 + tid]; }
            const float mean = s1 * (1.f / 1024.f), var = fmaxf(s2 * (1.f / 1024.f) - mean * mean, 0.f);
            stat[tid] = (f32x2){mean, 1.0f / sqrtf(var + LN_EPS)}; }
        __syncthreads();
        bf16* op = CA + (rowbase + half * 16) * 1024 + 2 * tid;
#pragma unroll
        for (int to = 0; to < 16; ++to) { if (to < ntok) { const f32x2 st = stat[to]; const unsigned za = zav[to];
            const float y0 = (acc[to].x - st.x) * st.y * lg0 + lbb0, y1 = (acc[to].y - st.x) * st.y * lg1 + lbb1;
            *(unsigned*)(op + (size_t)to * 1024) = cvt_pk_bf16(y0 * sigm(y0) * bf_lo(za), y1 * sigm(y1) * bf_hi(za)); }
            if ((to & 7) == 7) asm volatile("" ::: "memory"); }
    }
    __syncthreads();
}

__device__ __forceinline__ void combine_row(const bf16* Hb, const bf16* Og, const float* Lse, const float* Sp, bf16* AB, int row, int lane) {
    const int h = lane >> 3;
    float og[3][8], ls[3];
    if (row < RP) {
#pragma unroll
        for (int g = 0; g < 3; ++g) { ls[g] = Lse[((size_t)g * R + row) * 8 + h]; const u32x4 v = *(const u32x4*)(Og + ((size_t)g * R + row) * 512 + lane * 8);
            og[g][0] = bf_lo(v.x); og[g][1] = bf_hi(v.x); og[g][2] = bf_lo(v.y); og[g][3] = bf_hi(v.y); og[g][4] = bf_lo(v.z); og[g][5] = bf_hi(v.z); og[g][6] = bf_lo(v.w); og[g][7] = bf_hi(v.w); }
    } else {
        const int sr = row - RP, b = sr >> 3, t = sr & 7;
#pragma unroll
        for (int g = 0; g < 3; ++g) { const float* sp = Sp + (size_t)((((b * 3 + g) * 8 + t) * 8)) * 640 + lane;
            float mc[8], M = -INFINITY;
#pragma unroll
            for (int c = 0; c < 8; ++c) { mc[c] = sp[c * 640]; M = fmaxf(M, mc[c]); }
            float L = 0.f, oo[8];
#pragma unroll
            for (int i = 0; i < 8; ++i) oo[i] = 0.f;
#pragma unroll
            for (int c = 0; c < 8; ++c) { const float f = __builtin_amdgcn_exp2f(mc[c] - M); L += sp[c * 640 + 64] * f;
#pragma unroll
                for (int i = 0; i < 8; ++i) oo[i] += sp[c * 640 + 128 + 64 * i] * f; }
            const float li = 1.0f / L;
#pragma unroll
            for (int i = 0; i < 8; ++i) og[g][i] = oo[i] * li;
            ls[g] = (M + __builtin_amdgcn_logf(L)) * LN2; }
    }
    const float mx = fmaxf(ls[0], fmaxf(ls[1], ls[2]));
    const float e0 = __expf(ls[0] - mx), e1 = __expf(ls[1] - mx), e2 = __expf(ls[2] - mx), inv = 1.0f / (e0 + e1 + e2);
    const float w0 = e0 * inv, w1 = e1 * inv, w2 = e2 * inv;
    const u32x4 z = *(const u32x4*)(Hb + (size_t)row * HP + HC_ZB + lane * 8);
    float r[8];
#pragma unroll
    for (int i = 0; i < 8; ++i) r[i] = w0 * og[0][i] + w1 * og[1][i] + w2 * og[2][i];
    u32x4 o; o.x = cvt_pk_bf16(r[0] * bf_lo(z.x), r[1] * bf_hi(z.x)); o.y = cvt_pk_bf16(r[2] * bf_lo(z.y), r[3] * bf_hi(z.y));
    o.z = cvt_pk_bf16(r[4] * bf_lo(z.z), r[5] * bf_hi(z.z)); o.w = cvt_pk_bf16(r[6] * bf_lo(z.w), r[7] * bf_hi(z.w));
    *(u32x4*)(AB + (size_t)row * 512 + lane * 8) = o;
}

constexpr int NTAIL = 4;
__device__ __forceinline__ void kv_outputs(const Args& a, const bf16* Hs, const bf16* QKVh, int g_lo, int g_hi, int gtid, int gthreads) {
    for (int g = g_lo; g < g_hi; ++g) {
        const int keep = 128 << (2 * g), lg = 2 * g; const size_t nch = (size_t)8 * keep * 128;
        float* dst = a.out + (g == 0 ? O_KVP0 : g == 1 ? O_KVP1 : O_KVP2);
        for (size_t j = gtid; j < nch; j += gthreads) {
            const int c = (int)(j & 127), kv = c >> 6, cc = c & 63; const size_t bi = j >> 7; const int ii = (int)(bi % keep), b = (int)(bi / keep);
            const int t = SEQ - keep + ii, ti = ((t & ((1 << lg) - 1)) << (12 - lg)) + (t >> lg), hh = cc >> 3;
            const u32x4 v = *(const u32x4*)(QKVh + ((size_t)(((((kv + 1) * 8 + b) * 3 + g) * 8 + hh) * 4096 + ti)) * 64 + (cc & 7) * 8);
            f32x4* dp = (f32x4*)(dst + j * 8);
            dp[0] = (f32x4){bf_lo(v.x), bf_hi(v.x), bf_lo(v.y), bf_hi(v.y)}; dp[1] = (f32x4){bf_lo(v.z), bf_hi(v.z), bf_lo(v.w), bf_hi(v.w)};
        }
    }
    if (g_lo == 0) {
        for (int i = gtid; i < 32 * 3 * 8 * 128; i += gthreads) {
            const int c = i & 127, kv = c >> 6, cc = c & 63, t = (i >> 7) & 7, bg = i >> 10, g = bg % 3, b = bg / 3;
            const int wb = 128 << (2 * g);
            float* dst = a.out + (g == 0 ? O_KVS0 : g == 1 ? O_KVS1 : O_KVS2) + ((size_t)b * wb + wb - 8 + t) * 1024 + (size_t)c * 8;
            const u32x4 v = *(const u32x4*)(Hs + (size_t)(b * 8 + t) * HSP + (kv ? HS_V : HS_K) + g * 512 + cc * 8);
            ((f32x4*)dst)[0] = (f32x4){bf_lo(v.x), bf_hi(v.x), bf_lo(v.y), bf_hi(v.y)}; ((f32x4*)dst)[1] = (f32x4){bf_lo(v.z), bf_hi(v.z), bf_lo(v.w), bf_hi(v.w)};
        }
    }
}

__device__ __forceinline__ void combine_prompt4(const bf16* Hb, const bf16* Og, const float* Lse, bf16* AB, int row0, int lane) {
    const int h = lane >> 3;
    u32x4 ov[4][3], zv[4]; float ls[4][3];
#pragma unroll
    for (int k = 0; k < 4; ++k) { const size_t row = (size_t)(row0 + k);
#pragma unroll
        for (int g = 0; g < 3; ++g) { ls[k][g] = Lse[((size_t)g * R + row) * 8 + h]; ov[k][g] = *(const u32x4*)(Og + ((size_t)g * R + row) * 512 + lane * 8); }
        zv[k] = *(const u32x4*)(Hb + row * HP + HC_ZB + lane * 8); }
#pragma unroll
    for (int k = 0; k < 4; ++k) {
        const float mx = fmaxf(ls[k][0], fmaxf(ls[k][1], ls[k][2]));
        const float e0 = __expf(ls[k][0] - mx), e1 = __expf(ls[k][1] - mx), e2 = __expf(ls[k][2] - mx), inv = 1.0f / (e0 + e1 + e2);
        const float w0 = e0 * inv, w1 = e1 * inv, w2 = e2 * inv;
        const u32x4 a = ov[k][0], b = ov[k][1], c = ov[k][2], z = zv[k];
        u32x4 o;
        o.x = cvt_pk_bf16((w0 * bf_lo(a.x) + w1 * bf_lo(b.x) + w2 * bf_lo(c.x)) * bf_lo(z.x), (w0 * bf_hi(a.x) + w1 * bf_hi(b.x) + w2 * bf_hi(c.x)) * bf_hi(z.x));
        o.y = cvt_pk_bf16((w0 * bf_lo(a.y) + w1 * bf_lo(b.y) + w2 * bf_lo(c.y)) * bf_lo(z.y), (w0 * bf_hi(a.y) + w1 * bf_hi(b.y) + w2 * bf_hi(c.y)) * bf_hi(z.y));
        o.z = cvt_pk_bf16((w0 * bf_lo(a.z) + w1 * bf_lo(b.z) + w2 * bf_lo(c.z)) * bf_lo(z.z), (w0 * bf_hi(a.z) + w1 * bf_hi(b.z) + w2 * bf_hi(c.z)) * bf_hi(z.z));
        o.w = cvt_pk_bf16((w0 * bf_lo(a.w) + w1 * bf_lo(b.w) + w2 * bf_lo(c.w)) * bf_lo(z.w), (w0 * bf_hi(a.w) + w1 * bf_hi(b.w) + w2 * bf_hi(c.w)) * bf_hi(z.w));
        *(u32x4*)(AB + (size_t)(row0 + k) * 512 + lane * 8) = o;
    }
}

__device__ __forceinline__ float wave_sum(float v) {
#pragma unroll
    for (int o = 1; o < 64; o <<= 1) v += __shfl_xor(v, o);
    return v;
}

#define RLX_AGENT __ATOMIC_RELAXED, __HIP_MEMORY_SCOPE_AGENT
#define XB_TMO      128
#define XB_XCNT(j)  (256  + 64 * (j))
#define XB_XSUB(j)  (1280 + 64 * (j))
#define XB_XGEN(j)  (2304 + 64 * (j))
#define XB_TOP      3328
#define XB_TOPGEN   3392
#define XCD_BAR_WORDS 3456
#define XB_SPIN_CAP (1u << 18)

__device__ __forceinline__ unsigned xb_ld(unsigned* p)              { return __hip_atomic_load(p, __ATOMIC_RELAXED, __HIP_MEMORY_SCOPE_AGENT); }
__device__ __forceinline__ unsigned xb_add(unsigned* p, unsigned v) { return __hip_atomic_fetch_add(p, v, __ATOMIC_RELAXED, __HIP_MEMORY_SCOPE_AGENT); }
__device__ __forceinline__ unsigned xb_xcc_id() { return (unsigned)__builtin_amdgcn_s_getreg((3 << 11) | 20) & 0xFu; }
#define XB_SPIN(cond, bar) do { unsigned _sp = 0; while (cond) { __builtin_amdgcn_s_sleep(1); \
    if ((++_sp & 255u) == 0u) { if (xb_ld(&(bar)[XB_TMO])) break; if (_sp > XB_SPIN_CAP) { atomicAdd(&(bar)[XB_TMO], 1u); break; } } } } while (0)

struct XcdBarrier {
    unsigned* bar; unsigned x;
    volatile LAS unsigned* st;
};

__device__ __forceinline__ XcdBarrier xcd_barrier_post(unsigned* bar, volatile LAS unsigned* st) {
    XcdBarrier b; b.bar = bar; b.x = xb_xcc_id(); b.st = st;
    if (threadIdx.x == 0) (void)xb_add(&bar[XB_XCNT(b.x)], 1u);
    return b;
}
__device__ __forceinline__ void xcd_barrier_complete(unsigned* bar, unsigned x, unsigned& nloc, unsigned& nx) {
    const unsigned G = gridDim.x * gridDim.y * gridDim.z;
    unsigned sum, cnt, mine, sp = 0u;
    for (;;) {
        sum = 0u; cnt = 0u; mine = 0u;
#pragma unroll
        for (unsigned j = 0; j < 16; ++j) { const unsigned c = xb_ld(&bar[XB_XCNT(j)]); sum += c; cnt += (c > 0u) ? 1u : 0u; mine = (j == x) ? c : mine; }
        if (sum == G) break;
        __builtin_amdgcn_s_sleep(1);
        if ((++sp & 255u) == 0u) { if (xb_ld(&bar[XB_TMO])) break; if (sp > XB_SPIN_CAP) { atomicAdd(&bar[XB_TMO], 1u); break; } }
    }
    nloc = mine > 0u ? mine : 1u; nx = cnt > 0u ? cnt : 1u;
}

__device__ __forceinline__ void xcd_barrier(const XcdBarrier& b) {
    asm volatile("s_waitcnt vmcnt(0)" ::: "memory");
    __syncthreads();
    if (threadIdx.x == 0) {
        unsigned* bar = b.bar;
        __builtin_amdgcn_s_waitcnt(0);
        unsigned nloc = b.st[0], nx = b.st[1];
        if (nloc == 0u) { xcd_barrier_complete(bar, b.x, nloc, nx); b.st[0] = nloc; b.st[1] = nx; }
        const unsigned old = xb_add(&bar[XB_XSUB(b.x)], 1u);
        const unsigned gen = old / nloc;
        if (old + 1u == (gen + 1u) * nloc) {
            __builtin_amdgcn_fence(__ATOMIC_RELEASE, "agent");
            asm volatile("s_waitcnt vmcnt(0)" ::: "memory");
            const unsigned og = xb_add(&bar[XB_TOP], 1u);
            const unsigned tg = og / nx;
            if (og + 1u == (tg + 1u) * nx) xb_add(&bar[XB_TOPGEN], 1u);
            else XB_SPIN(xb_ld(&bar[XB_TOPGEN]) == tg, bar);
            __builtin_amdgcn_fence(__ATOMIC_ACQUIRE, "agent");
            xb_add(&bar[XB_XGEN(b.x)], 1u);
            asm volatile("s_waitcnt vmcnt(0)" ::: "memory");
        } else {
            XB_SPIN(xb_ld(&bar[XB_XGEN(b.x)]) == gen, bar);
            __builtin_amdgcn_fence(__ATOMIC_ACQUIRE, "agent");
            asm volatile("s_waitcnt vmcnt(0)" ::: "memory");
        }
    }
    __syncthreads();
}

__device__ __forceinline__ int fresh_tid() { int t; asm volatile("v_mov_b32 %0, %1" : "=v"(t) : "v"((int)threadIdx.x)); return t; }
#define FRESH_IDS() const int tid = fresh_tid(), lane = tid & 63, wave = __builtin_amdgcn_readfirstlane(tid >> 6)
__global__ void __launch_bounds__(NT, 2) fwd_mega(Args a) {
    extern __shared__ __attribute__((aligned(16))) unsigned char lds_raw[];
    cg::grid_group grid = cg::this_grid();
    LAS unsigned char* lds = (LAS unsigned char*)lds_raw;
    const int G = gridDim.x;
    if (threadIdx.x < 16) ((LAS unsigned*)(lds + LDS_MISC))[threadIdx.x] = 0u;
    unsigned* barw = (unsigned*)(a.ws + WS_BAR);
    if (blockIdx.x == 0) for (int i = threadIdx.x; i < XCD_BAR_WORDS; i += NT) barw[i] = 0u;
    __syncthreads();
    unsigned char* ws = a.ws;
    bf16* WinT = (bf16*)(ws + WS_WIN); bf16* WaT = (bf16*)(ws + WS_WA); bf16* WbT = (bf16*)(ws + WS_WB); bf16* WoT = (bf16*)(ws + WS_WO); float* bp = (float*)(ws + WS_BP); bf16* Xb = (bf16*)(ws + WS_XB);
    bf16* CA = (bf16*)(ws + WS_CA); bf16* AB = (bf16*)(ws + WS_AB); bf16* Mb = (bf16*)(ws + WS_MB); bf16* Og = (bf16*)(ws + WS_OG); float* Lse = (float*)(ws + WS_LSE); float* Sp = (float*)(ws + WS_SP); bf16* Hb = (bf16*)(ws + WS_HB); bf16* Hs = (bf16*)(ws + WS_HS); bf16* Ub = (bf16*)(ws + WS_U); bf16* ZAb = (bf16*)(ws + WS_ZA); bf16* QKVh = (bf16*)(ws + WS_QKV); bf16* Ypre = (bf16*)(ws + WS_Y);

    for (int rep = 0; rep < REP_P0; ++rep) { FRESH_IDS(); phase0(a, lds, tid, lane, wave, G);
    grid.sync(); }
    XcdBarrier xbar = xcd_barrier_post(barw, (volatile LAS unsigned*)(lds + LDS_MISC) + 8);

    for (int i = 0; i < REP_SYNC; ++i) xcd_barrier(xbar);
    for (int rep = 0; rep < REP_P1; ++rep) {
    { pg8::Gemm g{Xb, WinT, R, INW, D}; pg8::StaticOrder S; S.init(R, INW, G, (int)blockIdx.x);
      pg8::EpiIn E{Hb, Hs, Ub, ZAb, QKVh, bp, QS, a.c0, a.c1, a.c2, a.out + O_KVS0, a.out + O_KVS1, a.out + O_KVS2};
      pg8::gemm_phase<pg8::EpiIn, pg8::StaticOrder, true, true>(lds, g, S, E); }
    if (blockIdx.x >= 40) { FRESH_IDS();
      const int bi = blockIdx.x - 40, nb = G - 40;
      kvs_copy_range<2048>(a.c2, a.out + O_KVS2, (size_t)pg8::KVS_E * 4608, tid, bi, nb); kvs_copy_range<512>(a.c1, a.out + O_KVS1, 0, tid, bi, nb); kvs_copy_range<128>(a.c0, a.out + O_KVS0, 0, tid, bi, nb); }
    xcd_barrier(xbar); }

    { FRESH_IDS();
    AttnPre pre; int u = blockIdx.x;
    if (u < 3072 * REP_ATT) attn_load(QKVh, u % 3072, tid, lane, wave, pre);
    for (; u < 3072 * REP_ATT; u += G) {
        attn_stage(lds, pre, tid);
        bf16x8 qf[4];
#pragma unroll
        for (int kd = 0; kd < 4; ++kd) qf[kd] = pre.q[kd];
        __syncthreads();
        if (u + G < 3072 * REP_ATT) attn_load(QKVh, (u + G) % 3072, tid, lane, wave, pre);
        attn_compute(lds, qf, Og, Lse, u % 3072, tid, lane, wave);
        __syncthreads();
    } }
    { FRESH_IDS();
    for (int u = blockIdx.x; u < 768 * REP_SATT; u += G) sattn_task(a, Hs, Sp, (u % 768) * 8 + wave, lane); }
    { FRESH_IDS();
        const f32x2 cbv = *(const f32x2*)(a.conv_b + 2 * tid), lgv = *(const f32x2*)(a.cln_g + 2 * tid), lbv = *(const f32x2*)(a.cln_b + 2 * tid);
        for (int u = blockIdx.x; u < 1056 * REP_CONV; u += G) conv_tile(a, lds, Ub, ZAb, CA, u % 1056, tid, lane, wave, cbv.x, cbv.y, lgv.x, lgv.y, lbv.x, lbv.y);
    }
    xcd_barrier(xbar);

#define P3_BODY \
    { FRESH_IDS(); const int gw = blockIdx.x * NWAVES + wave; for (int q = gw; q < RP / 4; q += G * NWAVES) combine_prompt4(Hb, Og, Lse, AB, 4 * q, lane); \
      if (gw < RS) combine_row(Hb, Og, Lse, Sp, AB, RP + gw, lane); } \
    { pg8::Gemm g{CA, WaT, R, D, D}; pg8::StaticOrder S; S.init(R, D, G, (int)blockIdx.x); \
      pg8::EpiGate<false> E{Hb, Mb, HC_GA}; \
      pg8::gemm_phase<pg8::EpiGate<false>, pg8::StaticOrder, true, true>(lds, g, S, E); } \
    xcd_barrier(xbar); \
    { pg8::Gemm g{AB, WbT, R, D, 512}; pg8::StaticOrder S; S.init(R, D, G, (int)blockIdx.x); \
      pg8::EpiGate<true> E{Hb, Mb, HC_GB}; \
      pg8::gemm_phase<pg8::EpiGate<true>, pg8::StaticOrder, true, true>(lds, g, S, E); } \
    if (blockIdx.x >= NTAIL) { FRESH_IDS(); kv_outputs(a, Hs, QKVh, 0, 2, (blockIdx.x - NTAIL) * NT + tid, (G - NTAIL) * NT); } \
    xcd_barrier(xbar);
    P3_BODY
#if REP_P3 > 1
    P3_BODY
#endif
#undef P3_BODY

    for (int rep = 0; rep < REP_P4; ++rep) {
    { pg8::Gemm g{Mb, WoT, R, D, D}; pg8::StaticOrder S; S.init(R, D, G, (int)blockIdx.x);
      pg8::EpiOut E{a.xp, a.xs, Ypre, ALPHA, RP};
      pg8::gemm_phase<pg8::EpiOut, pg8::StaticOrder, true, true>(lds, g, S, E); }
    if (blockIdx.x >= NTAIL) { FRESH_IDS(); kv_outputs(a, Hs, QKVh, 2, 3, (blockIdx.x - NTAIL) * NT + tid, (G - NTAIL) * NT); }
    xcd_barrier(xbar); }

    for (int rep = 0; rep < REP_P5; ++rep) { FRESH_IDS();
        f32x4 gv[4], bv[4];
#pragma unroll
        for (int j = 0; j < 2; ++j) { gv[2 * j] = *(const f32x4*)(a.ln_g + 512 * j + 8 * lane); gv[2 * j + 1] = *(const f32x4*)(a.ln_g + 512 * j + 8 * lane + 4);
            bv[2 * j] = *(const f32x4*)(a.ln_b + 512 * j + 8 * lane); bv[2 * j + 1] = *(const f32x4*)(a.ln_b + 512 * j + 8 * lane + 4); }
        for (int q = blockIdx.x * NWAVES + wave; q < R / 4; q += G * NWAVES) {
            u32x4 raw[4][2]; f32x4 v[4][4]; float s[4], s2[4];
#pragma unroll
            for (int k = 0; k < 4; ++k)
#pragma unroll
                for (int j = 0; j < 2; ++j) raw[k][j] = *(const u32x4*)(Ypre + (size_t)(4 * q + k) * D + 512 * j + 8 * lane);
#pragma unroll
            for (int k = 0; k < 4; ++k) { s[k] = 0.f;
#pragma unroll
                for (int j = 0; j < 2; ++j) { const u32x4 r = raw[k][j]; v[k][2 * j] = (f32x4){bf_lo(r.x), bf_hi(r.x), bf_lo(r.y), bf_hi(r.y)}; v[k][2 * j + 1] = (f32x4){bf_lo(r.z), bf_hi(r.z), bf_lo(r.w), bf_hi(r.w)}; }
#pragma unroll
                for (int j = 0; j < 4; ++j) s[k] += (v[k][j].x + v[k][j].y) + (v[k][j].z + v[k][j].w); }
#pragma unroll
            for (int o = 1; o < 64; o <<= 1) {
#pragma unroll
                for (int k = 0; k < 4; ++k) s[k] += __shfl_xor(s[k], o); }
#pragma unroll
            for (int k = 0; k < 4; ++k) { const float mean = s[k] * (1.f / D); s2[k] = 0.f;
#pragma unroll
                for (int j = 0; j < 4; ++j) { v[k][j] = v[k][j] - mean; s2[k] += (v[k][j].x * v[k][j].x + v[k][j].y * v[k][j].y) + (v[k][j].z * v[k][j].z + v[k][j].w * v[k][j].w); } }
#pragma unroll
            for (int o = 1; o < 64; o <<= 1) {
#pragma unroll
                for (int k = 0; k < 4; ++k) s2[k] += __shfl_xor(s2[k], o); }
#pragma unroll
            for (int k = 0; k < 4; ++k) { const float rstd = 1.f / sqrtf(s2[k] * (1.f / D) + LN_EPS); float* yr = a.out + (size_t)(4 * q + k) * D + 8 * lane;
#pragma unroll
                for (int j = 0; j < 4; ++j) *(f32x4*)(yr + 512 * (j >> 1) + 4 * (j & 1)) = v[k][j] * rstd * gv[j] + bv[j]; }
        }
    }
}

extern "C" void kernel_launch(void* const* d_in, const int* in_sizes, int n_in, void* d_out, int out_size, void* d_ws, size_t ws_size, hipStream_t stream) {
    static int grid = 0;
    if (grid == 0) {
        if (n_in != 17 || out_size != 145145856 || ws_size < WS_END) { fprintf(stderr, "kernel_launch: unexpected problem shape / workspace (n_in %d out %d ws %zu)\n", n_in, out_size, ws_size); grid = -1; return; }
        int dev = 0, cus = 0, per_cu = 0;
        if (hipGetDevice(&dev) != hipSuccess || hipDeviceGetAttribute(&cus, hipDeviceAttributeMultiprocessorCount, dev) != hipSuccess) { grid = -1; return; }
        if (hipFuncSetAttribute((const void*)fwd_mega, hipFuncAttributeMaxDynamicSharedMemorySize, LDS_BYTES) != hipSuccess) { grid = -1; return; }
        if (hipOccupancyMaxActiveBlocksPerMultiprocessor(&per_cu, (const void*)fwd_mega, NT, LDS_BYTES) != hipSuccess || per_cu < 1) { fprintf(stderr, "kernel_launch: occupancy query gave %d\n", per_cu); grid = -1; return; }
        grid = cus * 1;
    }
    if (grid < 0) return;
    Args a{};
    a.xp = (const float*)d_in[0]; a.xs = (const float*)d_in[1]; a.c0 = (const float*)d_in[2]; a.c1 = (const float*)d_in[3]; a.c2 = (const float*)d_in[4]; a.sconv = (const float*)d_in[5];
    a.w_in = (const float*)d_in[6]; a.b_in = (const float*)d_in[7]; a.conv_w = (const float*)d_in[8]; a.conv_b = (const float*)d_in[9]; a.cln_g = (const float*)d_in[10]; a.cln_b = (const float*)d_in[11];
    a.w_a = (const float*)d_in[12]; a.w_b = (const float*)d_in[13]; a.w_out = (const float*)d_in[14]; a.ln_g = (const float*)d_in[15]; a.ln_b = (const float*)d_in[16];
    a.out = (float*)d_out; a.ws = (unsigned char*)d_ws;
    void* args[] = {&a};
    hipError_t e = hipLaunchCooperativeKernel((const void*)fwd_mega, dim3(grid), dim3(NT), args, LDS_BYTES, stream);
    if (e != hipSuccess) fprintf(stderr, "kernel_launch: cooperative launch failed: %s (grid %d)\n", hipGetErrorString(e), grid);
}
```
